# Optimizing an MI355X kernel written in HIP

```python
import jax
import jax.numpy as jnp
from jax import lax
import numpy as np

D_MODEL = 1024
BATCH = 1
SEQ = 16384
DEPTH = 1

POOL_WIDTH = D_MODEL
POOL_GROUPS = 4
POOL_GROUP_WIDTH = POOL_WIDTH // POOL_GROUPS
POOL_WINDOWS = (2, 4, 8, 16)
GLA_HEADS = 4
GLA_KEY_WIDTH = D_MODEL // 2
GLA_VALUE_WIDTH = D_MODEL
GLA_HEAD_K = GLA_KEY_WIDTH // GLA_HEADS
GLA_HEAD_V = GLA_VALUE_WIDTH // GLA_HEADS
GLA_GATE_RANK = 16
GLA_GATE_NORMALIZER = 16.0
GLA_CHUNK = 64
N_BRANCHES = 2
RMS_EPS = 1e-6
IN_SPLITS = (POOL_WIDTH, POOL_WIDTH, GLA_KEY_WIDTH, GLA_KEY_WIDTH, GLA_VALUE_WIDTH, GLA_VALUE_WIDTH, GLA_GATE_RANK, GLA_GATE_RANK, D_MODEL, D_MODEL)
IN_WIDTH = sum(IN_SPLITS)

kernel_name = "hybrid_pool_gla_gated_block"


def rms_norm(x, g):
    xf = x.astype(jnp.float32)
    xf = xf * lax.rsqrt(jnp.mean(xf * xf, axis=-1, keepdims=True) + RMS_EPS)
    return (xf * g.astype(jnp.float32)).astype(x.dtype)


def multiscale_pool(u):
    b, s, _ = u.shape
    ug = u.reshape(b, s, POOL_GROUPS, POOL_GROUP_WIDTH).astype(jnp.float32)
    csum = jnp.concatenate([jnp.zeros_like(ug[:, :1]), jnp.cumsum(ug, axis=1)], axis=1)
    pos = jnp.arange(s)
    outs = []
    for gi, w in enumerate(POOL_WINDOWS):
        lo = jnp.clip(pos - w // 2, 0, s)
        hi = jnp.clip(pos + w // 2, 0, s)
        cs = csum[:, :, gi]
        window_sum = jnp.take(cs, hi, axis=1) - jnp.take(cs, lo, axis=1)
        count = (hi - lo).astype(jnp.float32)[None, :, None]
        outs.append(window_sum / count - ug[:, :, gi])
    return jnp.stack(outs, axis=2).astype(u.dtype)


def gla_chunked(q, k, v, log_a, include_diag):
    b, s, h, dk = q.shape
    dv = v.shape[-1]
    n = s // GLA_CHUNK
    f32 = jnp.float32
    q = q.astype(f32).reshape(b, n, GLA_CHUNK, h, dk)
    k = k.astype(f32).reshape(b, n, GLA_CHUNK, h, dk)
    v = v.astype(f32).reshape(b, n, GLA_CHUNK, h, dv)
    la = log_a.astype(f32).reshape(b, n, GLA_CHUNK, h, dk)
    cum = jnp.cumsum(la, axis=2)
    q_dec = q * jnp.exp(cum)
    k_inv = k * jnp.exp(-cum)
    k_end = k * jnp.exp(cum[:, :, -1:] - cum)
    mask = jnp.tril(jnp.ones((GLA_CHUNK, GLA_CHUNK), dtype=bool), k=0 if include_diag else -1)
    scores = jnp.einsum('bnihd,bnjhd->bnhij', q_dec, k_inv)
    scores = jnp.where(mask, scores, 0.0)
    o_intra = jnp.einsum('bnhij,bnjhv->bnihv', scores, v)
    chunk_kv = jnp.einsum('bnjhd,bnjhv->nbhdv', k_end, v)
    chunk_decay = jnp.moveaxis(jnp.exp(cum[:, :, -1]), 1, 0)

    def step(state, inp):
        d, kv = inp
        return d[..., None] * state + kv, state

    _, states = lax.scan(step, jnp.zeros((b, h, dk, dv), f32), (chunk_decay, chunk_kv))
    o_inter = jnp.einsum('bnihd,nbhdv->bnihv', q_dec, states)
    return (o_intra + o_inter).reshape(b, s, h, dv)


def setup_inputs(seed: int = 0) -> dict:
    key = jax.random.key(seed)
    ks = jax.random.split(key, 20)

    def nrm(k, shape, scale):
        return jax.random.normal(k, shape, jnp.float32) * scale

    L = DEPTH
    return {
        "x": nrm(ks[0], (BATCH, SEQ, D_MODEL), 1.0),
        "c": nrm(ks[1], (BATCH, D_MODEL), 1.0),
        "w_ada": nrm(ks[2], (L, D_MODEL, 3 * D_MODEL), 0.5 * D_MODEL ** -0.5),
        "b_ada": nrm(ks[3], (L, 3 * D_MODEL), 0.02),
        "g_pre": 1.0 + nrm(ks[4], (L, D_MODEL), 0.02),
        "g_post": 1.0 + nrm(ks[5], (L, D_MODEL), 0.02),
        "w_in": nrm(ks[6], (L, D_MODEL, IN_WIDTH), D_MODEL ** -0.5),
        "pool_w": nrm(ks[7], (L, POOL_GROUPS, POOL_GROUP_WIDTH, POOL_GROUP_WIDTH), POOL_GROUP_WIDTH ** -0.5),
        "pool_scale": 1.0 + nrm(ks[8], (L, POOL_WIDTH), 0.02),
        "gk_up_fwd": nrm(ks[9], (L, GLA_GATE_RANK, GLA_KEY_WIDTH), GLA_GATE_RANK ** -0.5),
        "gk_bias_fwd": nrm(ks[10], (L, GLA_KEY_WIDTH), 0.02),
        "gk_up_bwd": nrm(ks[11], (L, GLA_GATE_RANK, GLA_KEY_WIDTH), GLA_GATE_RANK ** -0.5),
        "gk_bias_bwd": nrm(ks[12], (L, GLA_KEY_WIDTH), 0.02),
        "gla_norm_g": 1.0 + nrm(ks[13], (L, GLA_HEAD_V), 0.02),
        "w_proj_pool": nrm(ks[14], (L, POOL_WIDTH, D_MODEL), POOL_WIDTH ** -0.5),
        "w_proj_gla": nrm(ks[15], (L, GLA_VALUE_WIDTH, D_MODEL), GLA_VALUE_WIDTH ** -0.5),
        "w_out": nrm(ks[16], (L, D_MODEL, D_MODEL), D_MODEL ** -0.5),
    }


def reference(x, c, w_ada, b_ada, g_pre, g_post, w_in, pool_w, pool_scale, gk_up_fwd, gk_bias_fwd, gk_up_bwd, gk_bias_bwd, gla_norm_g, w_proj_pool, w_proj_gla, w_out):
    b, s, _ = x.shape
    split_idx = [int(v) for v in np.cumsum(IN_SPLITS)[:-1]]
    for l in range(DEPTH):
        ada = jax.nn.silu(c) @ w_ada[l] + b_ada[l]
        shift, scale, gate = jnp.split(ada[:, None, :], 3, axis=-1)
        h = rms_norm(x, g_pre[l]) * (1.0 + scale) + shift
        proj = h @ w_in[l]
        (p_in, p_gate, q, k, v, gla_gate, lr_f, lr_b, bg_pool, bg_gla) = jnp.split(proj, split_idx, axis=-1)

        pooled = multiscale_pool(p_in)
        a = jnp.einsum('bsgc,gcd->bsgd', pooled, pool_w[l]).reshape(b, s, POOL_WIDTH) * pool_scale[l]
        y_pool = (a * jax.nn.silu(p_gate)) @ w_proj_pool[l]

        q = q.reshape(b, s, GLA_HEADS, GLA_HEAD_K) * (GLA_HEAD_K ** -0.5)
        k = k.reshape(b, s, GLA_HEADS, GLA_HEAD_K)
        v = v.reshape(b, s, GLA_HEADS, GLA_HEAD_V)
        la_f = (jax.nn.log_sigmoid((lr_f @ gk_up_fwd[l] + gk_bias_fwd[l]).astype(jnp.float32)) / GLA_GATE_NORMALIZER).reshape(b, s, GLA_HEADS, GLA_HEAD_K)
        la_b = (jax.nn.log_sigmoid((lr_b @ gk_up_bwd[l] + gk_bias_bwd[l]).astype(jnp.float32)) / GLA_GATE_NORMALIZER).reshape(b, s, GLA_HEADS, GLA_HEAD_K)
        o_f = gla_chunked(q, k, v, la_f, True)
        o_b = jnp.flip(gla_chunked(jnp.flip(q, 1), jnp.flip(k, 1), jnp.flip(v, 1), jnp.flip(la_b, 1), False), 1)
        o = rms_norm((o_f + o_b).astype(x.dtype), gla_norm_g[l]).reshape(b, s, GLA_VALUE_WIDTH)
        y_gla = (o * jax.nn.silu(gla_gate)) @ w_proj_gla[l]

        merged = jax.nn.sigmoid(bg_pool) * y_pool + jax.nn.sigmoid(bg_gla) * y_gla
        out = merged @ w_out[l]
        x = x + gate * rms_norm(out, g_post[l])
    return x
```

```cpp
#include <hip/hip_runtime.h>
#include <hip/hip_cooperative_groups.h>
#include <cstdio>
#include <cstdint>
namespace cg = cooperative_groups;

#ifndef ONE_LAUNCH
#define ONE_LAUNCH 0
#endif

#define LAS __attribute__((address_space(3)))
typedef unsigned short bf16_t;
typedef short bf16x8 __attribute__((ext_vector_type(8)));
typedef float f32x4 __attribute__((ext_vector_type(4)));
typedef unsigned u32x4 __attribute__((ext_vector_type(4)));
typedef unsigned u32x2 __attribute__((ext_vector_type(2)));

constexpr int S = 16384, D = 1024, NPROJ = 7168, KW = 512, HK = 128, HV = 256, NH = 4, RANK = 16;
constexpr int CH = 64, SCN = 4, NSC = S / (CH * SCN);
constexpr float RMS_EPS = 1e-6f;
constexpr int NTHREADS = 512, NWAVES = 8;
constexpr int LDS_BYTES = 135168;

constexpr size_t MiB = 1u << 20;
constexpr size_t WS_CTL = 0, CTL_ZERO_BYTES = 128 * 1024;
constexpr size_t WS_ADA = 0, WS_ROWSQ = 16 * 1024, WS_BAR = 96 * 1024;
constexpr size_t WS_WIN = 1 * MiB;
constexpr size_t WS_WPP = 16 * MiB, WS_WPG = 18 * MiB, WS_WOUT = 20 * MiB, WS_POOLW = 22 * MiB;
constexpr size_t WS_LR = 23 * MiB;
constexpr size_t WS_LTOT = 25 * MiB;
constexpr size_t WS_PIN = 26 * MiB, WS_SPG = 58 * MiB, WS_Q = 90 * MiB, WS_K = 106 * MiB, WS_V = 122 * MiB, WS_SGG = 154 * MiB, WS_SBP = 186 * MiB, WS_SBG = 218 * MiB;
constexpr size_t WS_STATES = 26 * MiB;
constexpr size_t WS_END = 250 * MiB;

__device__ __forceinline__ unsigned cvt_pk_bf16(float lo, float hi) { unsigned r; asm volatile("v_cvt_pk_bf16_f32 %0, %1, %2" : "=v"(r) : "v"(lo), "v"(hi)); return r; }
__device__ __forceinline__ float bflo(unsigned u) { return __builtin_bit_cast(float, u << 16); }
__device__ __forceinline__ float bfhi(unsigned u) { return __builtin_bit_cast(float, u & 0xffff0000u); }
__device__ __forceinline__ float bf1(bf16_t u) { return __builtin_bit_cast(float, (unsigned)u << 16); }
__device__ __forceinline__ float sigmoidf_(float x) { return __builtin_amdgcn_rcpf(1.f + __expf(-x)); }
__device__ __forceinline__ float wave_sum(float v) {
#pragma unroll
    for (int o = 1; o < 64; o <<= 1) v += __shfl_xor(v, o);
    return v;
}

namespace pg8 {
constexpr int BM = 256, BK = 64, HALF = 128, HTB = HALF * BK * 2, NXCD = 8, WGM = 8;
__host__ __device__ __forceinline__ int lds_byte(int r, int c) { const int st = (r >> 4) * 2 + (c >> 5), rr = r & 15, cc = c & 31, ob = rr * 64 + cc * 2; return st * 1024 + (ob ^ (((ob >> 9) & 1) << 5)); }
__host__ __device__ __forceinline__ void stage_rc(int b, int& R, int& C) { const int st = b / 1024, sb = b % 1024, swz = sb ^ (((sb >> 9) & 1) << 5); R = (st >> 1) * 16 + swz / 64; C = (st & 1) * 32 + (swz % 64) / 2; }
__host__ __device__ __forceinline__ int perm32(int rho) { const int n = rho >> 4, i = rho & 15; return 8 * (i >> 2) + 4 * n + (i & 3); }

struct Unit { int pm, pn; };
struct Gemm { const bf16_t* A; const bf16_t* Bt; int M, N, K, lda, a_pn_off; };

struct StaticOrder {
    int nM, nN, nwg, G, c;
    __device__ void init(int M, int N, int G_, int c_) { nM = M / BM; nN = N / BM; nwg = nM * nN; G = G_; c = c_; }
    __device__ bool next(int i, Unit& u) const {
        const long L = (long)i * G + c; if (L >= nwg) return false;
        int wgid = (int)L; { const int q = nwg / NXCD, r = nwg % NXCD, xcd = wgid % NXCD, off = wgid / NXCD; wgid = (xcd < r ? xcd * (q + 1) : r * (q + 1) + (xcd - r) * q) + off; }
        const int nig = WGM * nN, gid = wgid / nig, fm = gid * WGM, gsz = (nM - fm) < WGM ? (nM - fm) : WGM;
        u.pm = fm + ((wgid % nig) % gsz); u.pn = (wgid % nig) / gsz; return true;
    }
};

template <class Epi>
__device__ __forceinline__ void gemm_phase(LAS unsigned char* lds, const Gemm g, const StaticOrder& S, const Epi& E) {
    const int tid = threadIdx.x, wid = __builtin_amdgcn_readfirstlane(tid >> 6), lane = tid & 63, wr = wid >> 2, wc = wid & 3, fr = lane & 15, fq = lane >> 4;
    const int K = g.K, nt = K / BK, lda = g.lda;
    unsigned voffA[2], voffB[2];
#pragma unroll
    for (int i = 0; i < 2; ++i) { int R, C; stage_rc(tid * 16 + i * 8192, R, C); const int Rb = (R & ~31) + perm32(R & 31);
        voffA[i] = (unsigned)(R * lda + C) * 2u; voffB[i] = (unsigned)(Rb * K + C) * 2u; }
    const size_t kstep = (size_t)(BK * 2);
    const size_t hstepA = (size_t)HALF * lda * 2, hstepB = (size_t)HALF * K * 2;
    const size_t tstepA = 2 * hstepA, tstepB = 2 * hstepB;
    const unsigned ldsw = (unsigned)wid * 1024u;
    const int aoff = lds_byte(wr * 64 + fr, fq * 8), boff = lds_byte(wc * 32 + fr, fq * 8);
#define PG8_SA(b, h) (((b) * 2 + (h)) * HTB)
#define PG8_SB(b, h) ((4 + (b) * 2 + (h)) * HTB)
#define PG8_STAGE(bufoff, gbase, voff) do { _Pragma("unroll") for (int _i = 0; _i < 2; ++_i) \
        __builtin_amdgcn_global_load_lds((const unsigned*)((const char*)(gbase) + (voff)[_i]), (LAS unsigned*)(lds + (bufoff) + ldsw + _i * 8192), 16, 0, 0); } while (0)
#define PG8_LDA(dst, b, h) do { _Pragma("unroll") for (int m = 0; m < 4; ++m) _Pragma("unroll") for (int k = 0; k < 2; ++k) dst[m][k] = *(const LAS bf16x8*)(lds + PG8_SA(b, h) + aoff + m * 2048 + k * 1024); } while (0)
#define PG8_LDB(dst, b, h) do { _Pragma("unroll") for (int n = 0; n < 2; ++n) _Pragma("unroll") for (int k = 0; k < 2; ++k) dst[n][k] = *(const LAS bf16x8*)(lds + PG8_SB(b, h) + boff + n * 2048 + k * 1024); } while (0)
#define PG8_MMA(ai, bj, At, Bt) do { __builtin_amdgcn_s_setprio(1); _Pragma("unroll") for (int m = 0; m < 4; ++m) _Pragma("unroll") for (int n = 0; n < 2; ++n) _Pragma("unroll") for (int k = 0; k < 2; ++k) \
        acc[ai][bj][m][n] = __builtin_amdgcn_mfma_f32_16x16x32_bf16(Bt[n][k], At[m][k], acc[ai][bj][m][n], 0, 0, 0); __builtin_amdgcn_s_setprio(0); } while (0)
#define PG8_WAIT_V(n) asm volatile("s_waitcnt vmcnt(" #n ")" ::: "memory")
#define PG8_WAIT_L(n) asm volatile("s_waitcnt lgkmcnt(" #n ")" ::: "memory")
#define PG8_BAR __builtin_amdgcn_s_barrier()
#define PG8_SCHED __builtin_amdgcn_sched_barrier(0)
    Unit cur, nxt; int ui = 0;
    if (!S.next(0, cur)) return;
    f32x4 acc[2][2][4][2];
#pragma unroll
    for (int a = 0; a < 2; ++a)
#pragma unroll
        for (int b = 0; b < 2; ++b)
#pragma unroll
            for (int m = 0; m < 4; ++m)
#pragma unroll
                for (int n = 0; n < 2; ++n) acc[a][b][m][n] = (f32x4){0.f, 0.f, 0.f, 0.f};
    bf16x8 At[4][2], B0[2][2], B1[2][2];
    const char* cA = (const char*)g.A + (size_t)cur.pm * tstepA + (size_t)cur.pn * g.a_pn_off * 2; const char* cB = (const char*)g.Bt + (size_t)cur.pn * tstepB;
    PG8_STAGE(PG8_SB(0, 0), cB, voffB); PG8_STAGE(PG8_SB(0, 1), cB + hstepB, voffB); PG8_STAGE(PG8_SA(0, 0), cA, voffA); PG8_STAGE(PG8_SA(0, 1), cA + hstepA, voffA);
    if (wr == 1) PG8_BAR;
    PG8_WAIT_V(2); PG8_BAR;
    PG8_STAGE(PG8_SB(1, 0), cB + kstep, voffB); PG8_STAGE(PG8_SA(1, 0), cA + kstep, voffA); PG8_STAGE(PG8_SB(1, 1), cB + hstepB + kstep, voffB);
    PG8_WAIT_V(6); PG8_BAR;
    for (;;) {
        const bool has_next = S.next(ui + 1, nxt);
        const char* nA = has_next ? (const char*)g.A + (size_t)nxt.pm * tstepA + (size_t)nxt.pn * g.a_pn_off * 2 : cA; const char* nB = has_next ? (const char*)g.Bt + (size_t)nxt.pn * tstepB : cB;
        for (int t = 0; t < nt; t += 2) {
            const bool last = (t == nt - 2);
            const char* a1 = cA + (size_t)(t + 1) * kstep;
            const char* a2 = last ? nA : cA + (size_t)(t + 2) * kstep; const char* b2 = last ? nB : cB + (size_t)(t + 2) * kstep;
            const char* a3 = a2 + kstep; const char* b3 = b2 + kstep;
            PG8_LDB(B0, 0, 0); PG8_LDB(B1, 0, 1); PG8_SCHED; PG8_LDA(At, 0, 0); PG8_STAGE(PG8_SA(1, 1), a1 + hstepA, voffA);
            PG8_WAIT_V(8); PG8_WAIT_L(0); PG8_BAR; PG8_MMA(0, 0, At, B0); PG8_MMA(0, 1, At, B1); PG8_BAR; PG8_SCHED;
            PG8_LDA(At, 0, 1); PG8_STAGE(PG8_SB(0, 0), b2, voffB); PG8_STAGE(PG8_SB(0, 1), b2 + hstepB, voffB); PG8_STAGE(PG8_SA(0, 0), a2, voffA);
            PG8_WAIT_V(8); PG8_WAIT_L(0); PG8_BAR; PG8_MMA(1, 0, At, B0); PG8_MMA(1, 1, At, B1); PG8_BAR; PG8_SCHED;
            PG8_LDB(B0, 1, 0); PG8_LDB(B1, 1, 1); PG8_SCHED; PG8_LDA(At, 1, 0); PG8_STAGE(PG8_SA(0, 1), a2 + hstepA, voffA);
            PG8_WAIT_V(8); PG8_WAIT_L(0); PG8_BAR; PG8_MMA(0, 0, At, B0); PG8_MMA(0, 1, At, B1); PG8_BAR; PG8_SCHED;
            PG8_LDA(At, 1, 1); PG8_STAGE(PG8_SB(1, 0), b3, voffB); PG8_STAGE(PG8_SB(1, 1), b3 + hstepB, voffB); PG8_STAGE(PG8_SA(1, 0), a3, voffA);
            PG8_WAIT_V(8); PG8_WAIT_L(0); PG8_BAR; PG8_MMA(1, 0, At, B0); PG8_MMA(1, 1, At, B1); PG8_BAR; PG8_SCHED;
        }
        if (wr == 0) PG8_BAR;
        E(acc, cur, wr, wc, fr, fq);
        if (!has_next) break;
#pragma unroll
        for (int a = 0; a < 2; ++a)
#pragma unroll
            for (int b = 0; b < 2; ++b)
#pragma unroll
                for (int m = 0; m < 4; ++m)
#pragma unroll
                    for (int n = 0; n < 2; ++n) acc[a][b][m][n] = (f32x4){0.f, 0.f, 0.f, 0.f};
        cur = nxt; cA = nA; cB = nB; ++ui;
        if (wr == 1) PG8_BAR;
    }
    PG8_WAIT_V(0);
    PG8_BAR;
#undef PG8_SA
#undef PG8_SB
#undef PG8_STAGE
#undef PG8_LDA
#undef PG8_LDB
#undef PG8_MMA
#undef PG8_WAIT_V
#undef PG8_WAIT_L
#undef PG8_BAR
#undef PG8_SCHED
}

__device__ __forceinline__ u32x4 pack8(f32x4 v0, f32x4 v1) { u32x4 w; w.x = cvt_pk_bf16(v0[0], v0[1]); w.y = cvt_pk_bf16(v0[2], v0[3]); w.z = cvt_pk_bf16(v1[0], v1[1]); w.w = cvt_pk_bf16(v1[2], v1[3]); return w; }
__device__ __forceinline__ void unpack8(u32x4 w, f32x4& v0, f32x4& v1) { v0 = (f32x4){bflo(w.x), bfhi(w.x), bflo(w.y), bfhi(w.y)}; v1 = (f32x4){bflo(w.z), bfhi(w.z), bflo(w.w), bfhi(w.w)}; }

struct EpiProj {
    unsigned char* ws;
    __device__ __forceinline__ void operator()(const f32x4 (&acc)[2][2][4][2], const Unit& u, int wr, int wc, int fr, int fq) const {
        const int t = u.pn; size_t off; int pitch, colt, act; float sc = 1.f;
        if (t < 4)       { off = WS_PIN; pitch = D;  colt = t * 256;        act = 0; }
        else if (t < 8)  { off = WS_SPG; pitch = D;  colt = (t - 4) * 256;  act = 1; }
        else if (t < 10) { off = WS_Q;   pitch = KW; colt = (t - 8) * 256;  act = 0; sc = 0.08838834764831845f; }
        else if (t < 12) { off = WS_K;   pitch = KW; colt = (t - 10) * 256; act = 0; }
        else if (t < 16) { off = WS_V;   pitch = D;  colt = (t - 12) * 256; act = 0; }
        else if (t < 20) { off = WS_SGG; pitch = D;  colt = (t - 16) * 256; act = 1; }
        else if (t < 24) { off = WS_SBP; pitch = D;  colt = (t - 20) * 256; act = 2; }
        else             { off = WS_SBG; pitch = D;  colt = (t - 24) * 256; act = 2; }
        bf16_t* base = (bf16_t*)(ws + off);
        const int row0 = u.pm * BM + wr * 64 + fr, col0 = colt + wc * 32 + 8 * fq;
#pragma unroll
        for (int ai = 0; ai < 2; ++ai)
#pragma unroll
            for (int m = 0; m < 4; ++m) { bf16_t* rowp = base + (size_t)(row0 + ai * HALF + m * 16) * pitch + col0;
#pragma unroll
                for (int bj = 0; bj < 2; ++bj) { f32x4 v0 = acc[ai][bj][m][0], v1 = acc[ai][bj][m][1];
                    if (act == 1) {
#pragma unroll
                        for (int e = 0; e < 4; ++e) { v0[e] = v0[e] * sigmoidf_(v0[e]); v1[e] = v1[e] * sigmoidf_(v1[e]); }
                    } else if (act == 2) {
#pragma unroll
                        for (int e = 0; e < 4; ++e) { v0[e] = sigmoidf_(v0[e]); v1[e] = sigmoidf_(v1[e]); }
                    } else { v0 = v0 * sc; v1 = v1 * sc; }
                    *(u32x4*)(rowp + bj * HALF) = pack8(v0, v1); } }
    }
};
struct EpiPool {
    const bf16_t* spg; bf16_t* a2; const float* pscale;
    __device__ __forceinline__ void operator()(const f32x4 (&acc)[2][2][4][2], const Unit& u, int wr, int wc, int fr, int fq) const {
        const int row0 = u.pm * BM + wr * 64 + fr, col0 = u.pn * BM + wc * 32 + 8 * fq;
        f32x4 ps[2][2];
#pragma unroll
        for (int bj = 0; bj < 2; ++bj) { ps[bj][0] = *(const f32x4*)(pscale + col0 + bj * HALF); ps[bj][1] = *(const f32x4*)(pscale + col0 + bj * HALF + 4); }
#pragma unroll
        for (int ai = 0; ai < 2; ++ai)
#pragma unroll
            for (int m = 0; m < 4; ++m) { const size_t ro = (size_t)(row0 + ai * HALF + m * 16) * D + col0;
#pragma unroll
                for (int bj = 0; bj < 2; ++bj) { f32x4 g0, g1; unpack8(*(const u32x4*)(spg + ro + bj * HALF), g0, g1);
                    f32x4 v0 = acc[ai][bj][m][0] * ps[bj][0] * g0, v1 = acc[ai][bj][m][1] * ps[bj][1] * g1;
                    *(u32x4*)(a2 + ro + bj * HALF) = pack8(v0, v1); } }
    }
};
struct EpiYPool {
    bf16_t* sbp;
    __device__ __forceinline__ void operator()(const f32x4 (&acc)[2][2][4][2], const Unit& u, int wr, int wc, int fr, int fq) const {
        const int row0 = u.pm * BM + wr * 64 + fr, col0 = u.pn * BM + wc * 32 + 8 * fq;
#pragma unroll
        for (int ai = 0; ai < 2; ++ai)
#pragma unroll
            for (int m = 0; m < 4; ++m) { const size_t ro = (size_t)(row0 + ai * HALF + m * 16) * D + col0;
#pragma unroll
                for (int bj = 0; bj < 2; ++bj) { f32x4 g0, g1; unpack8(*(const u32x4*)(sbp + ro + bj * HALF), g0, g1);
                    *(u32x4*)(sbp + ro + bj * HALF) = pack8(acc[ai][bj][m][0] * g0, acc[ai][bj][m][1] * g1); } }
    }
};
struct EpiYGla {
    const bf16_t* sbp; bf16_t* sbg;
    __device__ __forceinline__ void operator()(const f32x4 (&acc)[2][2][4][2], const Unit& u, int wr, int wc, int fr, int fq) const {
        const int row0 = u.pm * BM + wr * 64 + fr, col0 = u.pn * BM + wc * 32 + 8 * fq;
#pragma unroll
        for (int ai = 0; ai < 2; ++ai)
#pragma unroll
            for (int m = 0; m < 4; ++m) { const size_t ro = (size_t)(row0 + ai * HALF + m * 16) * D + col0;
#pragma unroll
                for (int bj = 0; bj < 2; ++bj) { f32x4 g0, g1, p0, p1; unpack8(*(const u32x4*)(sbg + ro + bj * HALF), g0, g1); unpack8(*(const u32x4*)(sbp + ro + bj * HALF), p0, p1);
                    *(u32x4*)(sbg + ro + bj * HALF) = pack8(p0 + acc[ai][bj][m][0] * g0, p1 + acc[ai][bj][m][1] * g1); } }
    }
};
struct EpiOut {
    float* out; float* rowsq;
    __device__ __forceinline__ void operator()(const f32x4 (&acc)[2][2][4][2], const Unit& u, int wr, int wc, int fr, int fq) const {
        const int row0 = u.pm * BM + wr * 64 + fr, col0 = u.pn * BM + wc * 32 + 8 * fq;
#pragma unroll
        for (int ai = 0; ai < 2; ++ai)
#pragma unroll
            for (int m = 0; m < 4; ++m) { const int row = row0 + ai * HALF + m * 16; float* rowp = out + (size_t)row * D + col0; float ss = 0.f;
#pragma unroll
                for (int bj = 0; bj < 2; ++bj) { const f32x4 v0 = acc[ai][bj][m][0], v1 = acc[ai][bj][m][1];
                    *(f32x4*)(rowp + bj * HALF) = v0; *(f32x4*)(rowp + bj * HALF + 4) = v1;
                    ss += (v0[0] * v0[0] + v0[1] * v0[1]) + (v0[2] * v0[2] + v0[3] * v0[3]) + (v1[0] * v1[0] + v1[1] * v1[1]) + (v1[2] * v1[2] + v1[3] * v1[3]); }
                ss += __shfl_xor(ss, 16); ss += __shfl_xor(ss, 32);
                if (fq == 0) atomicAdd(rowsq + row, ss); }
    }
};
}

__device__ __forceinline__ void transpose_item(const float* W, int K, int N, bf16_t* WT, int k0, int n0, int drow, LAS float* scr, int lane) {
#pragma unroll 8
    for (int i = 0; i < 32; ++i) { const int kk = 2 * i + (lane >> 5); scr[kk * 33 + (lane & 31)] = W[(size_t)(k0 + kk) * N + n0 + (lane & 31)]; }
    asm volatile("s_waitcnt lgkmcnt(0)" ::: "memory");
    const int c = lane & 7;
#pragma unroll
    for (int j = 0; j < 4; ++j) { const int n = (lane >> 3) + 8 * j; const LAS float* s = scr + (8 * c) * 33 + n;
        u32x4 o; o.x = cvt_pk_bf16(s[0 * 33], s[1 * 33]); o.y = cvt_pk_bf16(s[2 * 33], s[3 * 33]); o.z = cvt_pk_bf16(s[4 * 33], s[5 * 33]); o.w = cvt_pk_bf16(s[6 * 33], s[7 * 33]);
        *(u32x4*)(WT + (size_t)(drow + n) * K + k0 + 8 * c) = o; }
    asm volatile("s_waitcnt lgkmcnt(0)" ::: "memory");
}

constexpr int P_QD = 272, P_T = 144;
constexpr int L_QD = 0, L_KI = L_QD + 64 * P_QD, L_KET = L_KI + 64 * P_QD, L_VT = L_KET + 128 * P_T, L_SC = L_VT + 256 * P_T, L_DEC = L_SC + 64 * P_T,
              L_SEG = L_DEC + 512, L_LR = L_SEG + 2048, L_RS = L_LR + 8192, L_UP = L_RS + 2048, L_GLA_END = L_UP + 8192;
static_assert(L_GLA_END <= LDS_BYTES, "GLA LDS map");

template <bool NEED_O>
__device__ __forceinline__ void gla_chunk(LAS unsigned char* lds, const int tid_in, const int row0, const int h, const int dir,
        const bf16_t* __restrict__ Qb, const bf16_t* __restrict__ Kb, const bf16_t* __restrict__ Vb, const float* __restrict__ LR,
        const float bias, f32x4 (&St)[8][2], float& ltot,
        float* OF, bf16_t* SGG, const float* __restrict__ gnorm) {
    int tid = tid_in; asm volatile("" : "+v"(tid));
    const int w = __builtin_amdgcn_readfirstlane(tid >> 6);
    const int d = tid & 127, seg = tid >> 7;
    __syncthreads();
    ((LAS f32x4*)(lds + L_LR))[tid] = ((const f32x4*)(LR + (size_t)row0 * 32))[tid];
    {
        const int dv = tid & 255, half = tid >> 8;
        const bf16_t* vp = Vb + (size_t)(row0 + half * 32) * D + h * HV + dv;
        unsigned pk[16];
#pragma unroll
        for (int r = 0; r < 16; ++r) { const unsigned lo = vp[(size_t)(2 * r) * D], hi = vp[(size_t)(2 * r + 1) * D]; pk[r] = lo | (hi << 16); }
        LAS unsigned char* vt = lds + L_VT + dv * P_T + half * 64;
#pragma unroll
        for (int q = 0; q < 4; ++q) *(LAS u32x4*)(vt + q * 16) = (u32x4){pk[4 * q], pk[4 * q + 1], pk[4 * q + 2], pk[4 * q + 3]};
    }
    __syncthreads();
    float arr[16];
    {
        const LAS float* upl = (const LAS float*)(lds + L_UP) + d;
        float up[16];
#pragma unroll
        for (int m = 0; m < 16; ++m) up[m] = upl[m * 128];
        const LAS f32x4* lp = (const LAS f32x4*)(lds + L_LR + (seg * 16 * 32 + dir * 16) * 4);
#pragma unroll
        for (int r = 0; r < 16; ++r) {
            float z = bias;
#pragma unroll
            for (int q = 0; q < 4; ++q) { const f32x4 l4 = lp[r * 8 + q]; z += l4[0] * up[4 * q] + l4[1] * up[4 * q + 1] + l4[2] * up[4 * q + 2] + l4[3] * up[4 * q + 3]; }
            arr[r] = (fminf(z, 0.f) - __logf(1.f + __expf(-fabsf(z)))) * (1.f / 16.f);
        }
    }
    if (dir == 0) {
#pragma unroll
        for (int r = 1; r < 16; ++r) arr[r] += arr[r - 1];
    } else {
#pragma unroll
        for (int r = 14; r >= 0; --r) arr[r] += arr[r + 1];
    }
    ((LAS float*)(lds + L_SEG))[seg * 128 + d] = (dir == 0) ? arr[15] : arr[0];
    __syncthreads();
    float tot, off;
    {
        const LAS float* sg = (const LAS float*)(lds + L_SEG);
        const float s0 = sg[d], s1 = sg[128 + d], s2 = sg[256 + d], s3 = sg[384 + d];
        tot = (s0 + s1) + (s2 + s3);
        if (dir == 0) off = (seg > 0 ? s0 : 0.f) + (seg > 1 ? s1 : 0.f) + (seg > 2 ? s2 : 0.f);
        else          off = (seg < 1 ? s1 : 0.f) + (seg < 2 ? s2 : 0.f) + (seg < 3 ? s3 : 0.f);
        if (seg == 0) { ((LAS float*)(lds + L_DEC))[d] = __expf(tot); ltot += tot; }
    }
    {
        unsigned kep[8];
        const bf16_t* kp = Kb + (size_t)(row0 + seg * 16) * KW + h * HK + d;
        const bf16_t* qp = Qb + (size_t)(row0 + seg * 16) * KW + h * HK + d;
        LAS unsigned char* qd = lds + L_QD + (seg * 16) * P_QD + d * 2;
#pragma unroll
        for (int r2 = 0; r2 < 8; ++r2) {
            float ke2[2];
#pragma unroll
            for (int e = 0; e < 2; ++e) { const int r = 2 * r2 + e; const float cum = arr[r] + off; const float kf = bf1(kp[(size_t)r * KW]);
                ke2[e] = kf * __expf(tot - cum);
                if (NEED_O) { const float qf = bf1(qp[(size_t)r * KW]);
                    *(LAS bf16_t*)(qd + r * P_QD) = (bf16_t)(cvt_pk_bf16(qf * __expf(cum), 0.f) & 0xffffu);
                    *(LAS bf16_t*)(qd + (L_KI - L_QD) + r * P_QD) = (bf16_t)(cvt_pk_bf16(kf * __expf(-cum), 0.f) & 0xffffu); } }
            kep[r2] = cvt_pk_bf16(ke2[0], ke2[1]);
        }
        LAS unsigned char* kt = lds + L_KET + d * P_T + seg * 32;
        *(LAS u32x4*)(kt) = (u32x4){kep[0], kep[1], kep[2], kep[3]}; *(LAS u32x4*)(kt + 16) = (u32x4){kep[4], kep[5], kep[6], kep[7]};
    }
    __syncthreads();
    asm volatile("" : "+v"(tid));
    const int fr = tid & 15, fq = (tid & 63) >> 4;
    if (NEED_O) {
        {
            const int it = w >> 1, jt0 = (w & 1) * 2;
            f32x4 p[2] = {(f32x4){0.f, 0.f, 0.f, 0.f}, (f32x4){0.f, 0.f, 0.f, 0.f}};
            const LAS unsigned char* qb_ = lds + L_QD + fr * P_QD + fq * 16 + it * 16 * P_QD;
            const LAS unsigned char* kb_ = lds + L_KI + fr * P_QD + fq * 16 + jt0 * 16 * P_QD;
#pragma unroll
            for (int ks = 0; ks < 4; ++ks) {
                const bf16x8 qf = *(const LAS bf16x8*)(qb_ + ks * 64);
#pragma unroll
                for (int t = 0; t < 2; ++t) { const bf16x8 kf = *(const LAS bf16x8*)(kb_ + t * 16 * P_QD + ks * 64);
                    p[t] = __builtin_amdgcn_mfma_f32_16x16x32_bf16(kf, qf, p[t], 0, 0, 0); } }
            LAS unsigned char* sw = lds + L_SC + (it * 16 + fr) * P_T + (jt0 * 16 + fq * 4) * 2;
#pragma unroll
            for (int t = 0; t < 2; ++t) { const int i = it * 16 + fr, jb = (jt0 + t) * 16 + fq * 4; float v[4];
#pragma unroll
                for (int jj = 0; jj < 4; ++jj) { const int j = jb + jj; const bool keep = (dir == 0) ? (j <= i) : (j > i); v[jj] = keep ? p[t][jj] : 0.f; }
                *(LAS u32x2*)(sw + t * 32) = (u32x2){cvt_pk_bf16(v[0], v[1]), cvt_pk_bf16(v[2], v[3])}; }
        }
        __syncthreads();
        f32x4 o[4][2];
#pragma unroll
        for (int a = 0; a < 4; ++a) { o[a][0] = (f32x4){0.f, 0.f, 0.f, 0.f}; o[a][1] = (f32x4){0.f, 0.f, 0.f, 0.f}; }
        {
            const LAS unsigned char* vb_ = lds + L_VT + ((2 * w) * 16 + fr) * P_T + fq * 16;
            const LAS unsigned char* sb_ = lds + L_SC + fr * P_T + fq * 16;
#pragma unroll
            for (int ks = 0; ks < 2; ++ks) { bf16x8 vf[2];
#pragma unroll
                for (int bb = 0; bb < 2; ++bb) vf[bb] = *(const LAS bf16x8*)(vb_ + bb * 16 * P_T + ks * 64);
#pragma unroll
                for (int a = 0; a < 4; ++a) { const bf16x8 sf = *(const LAS bf16x8*)(sb_ + a * 16 * P_T + ks * 64);
#pragma unroll
                    for (int bb = 0; bb < 2; ++bb) o[a][bb] = __builtin_amdgcn_mfma_f32_16x16x32_bf16(sf, vf[bb], o[a][bb], 0, 0, 0); } }
            const LAS unsigned char* qa_ = lds + L_QD + fr * P_QD + fq * 8;
#pragma unroll
            for (int p = 0; p < 4; ++p) { bf16x8 sb[2];
#pragma unroll
                for (int bb = 0; bb < 2; ++bb) { const f32x4 s0 = St[2 * p][bb], s1 = St[2 * p + 1][bb];
                    const u32x4 pk = (u32x4){cvt_pk_bf16(s0[0], s0[1]), cvt_pk_bf16(s0[2], s0[3]), cvt_pk_bf16(s1[0], s1[1]), cvt_pk_bf16(s1[2], s1[3])};
                    sb[bb] = __builtin_bit_cast(bf16x8, pk); }
#pragma unroll
                for (int a = 0; a < 4; ++a) {
                    const u32x2 lo = *(const LAS u32x2*)(qa_ + a * 16 * P_QD + p * 64), hi = *(const LAS u32x2*)(qa_ + a * 16 * P_QD + p * 64 + 32);
                    const bf16x8 qa = __builtin_bit_cast(bf16x8, (u32x4){lo.x, lo.y, hi.x, hi.y});
#pragma unroll
                    for (int bb = 0; bb < 2; ++bb) o[a][bb] = __builtin_amdgcn_mfma_f32_16x16x32_bf16(qa, sb[bb], o[a][bb], 0, 0, 0); }
                __builtin_amdgcn_sched_barrier(0); }
        }
        {
        float* ofp = OF + (size_t)row0 * D + h * HV; bf16_t* sgp = SGG + (size_t)row0 * D + h * HV;
        const unsigned vo = (unsigned)((fq * 4) * D + (2 * w) * 16 + fr);
        if (dir == 0) {
#pragma unroll
            for (int a = 0; a < 4; ++a) {
#pragma unroll
                for (int bb = 0; bb < 2; ++bb)
#pragma unroll
                    for (int jj = 0; jj < 4; ++jj) ofp[vo + (unsigned)((a * 16 + jj) * D + bb * 16)] = o[a][bb][jj];
                __builtin_amdgcn_sched_barrier(0); }
        } else {
            float ss[4][4];
#pragma unroll
            for (int a = 0; a < 4; ++a) {
#pragma unroll
                for (int jj = 0; jj < 4; ++jj) { float s = 0.f;
#pragma unroll
                    for (int bb = 0; bb < 2; ++bb) { o[a][bb][jj] += ofp[vo + (unsigned)((a * 16 + jj) * D + bb * 16)]; s += o[a][bb][jj] * o[a][bb][jj]; }
                    s += __shfl_xor(s, 1); s += __shfl_xor(s, 2); s += __shfl_xor(s, 4); s += __shfl_xor(s, 8); ss[a][jj] = s; }
                __builtin_amdgcn_sched_barrier(0); }
            if (fr == 0) {
#pragma unroll
                for (int a = 0; a < 4; ++a) *(LAS f32x4*)(lds + L_RS + (w * 64 + a * 16 + fq * 4) * 4) = (f32x4){ss[a][0], ss[a][1], ss[a][2], ss[a][3]};
            }
            __syncthreads();
            float gn[2];
#pragma unroll
            for (int bb = 0; bb < 2; ++bb) gn[bb] = gnorm[(2 * w + bb) * 16 + fr];
#pragma unroll
            for (int a = 0; a < 4; ++a) { f32x4 t4 = (f32x4){0.f, 0.f, 0.f, 0.f};
#pragma unroll
                for (int ww = 0; ww < 8; ++ww) t4 += *(const LAS f32x4*)(lds + L_RS + (ww * 64 + a * 16 + fq * 4) * 4);
#pragma unroll
                for (int jj = 0; jj < 4; ++jj) { const float rstd = __builtin_amdgcn_rsqf(t4[jj] * (1.f / HV) + RMS_EPS);
#pragma unroll
                    for (int bb = 0; bb < 2; ++bb) { const unsigned idx = vo + (unsigned)((a * 16 + jj) * D + bb * 16);
                        const float gate = bf1(sgp[idx]);
                        sgp[idx] = (bf16_t)(cvt_pk_bf16(o[a][bb][jj] * rstd * gn[bb] * gate, 0.f) & 0xffffu); } }
                __builtin_amdgcn_sched_barrier(0); }
        }
        }
    }
    {
        const LAS unsigned char* dp = lds + L_DEC + fq * 16;
#pragma unroll
        for (int a = 0; a < 8; ++a) { const f32x4 dc = *(const LAS f32x4*)(dp + a * 64); St[a][0] *= dc; St[a][1] *= dc; }
        const LAS unsigned char* vb_ = lds + L_VT + ((2 * w) * 16 + fr) * P_T + fq * 16;
        const LAS unsigned char* kb_ = lds + L_KET + fr * P_T + fq * 16;
#pragma unroll
        for (int ks = 0; ks < 2; ++ks) { bf16x8 vf[2];
#pragma unroll
            for (int bb = 0; bb < 2; ++bb) vf[bb] = *(const LAS bf16x8*)(vb_ + bb * 16 * P_T + ks * 64);
#pragma unroll
            for (int a = 0; a < 8; ++a) { const bf16x8 kf = *(const LAS bf16x8*)(kb_ + a * 16 * P_T + ks * 64);
#pragma unroll
                for (int bb = 0; bb < 2; ++bb) St[a][bb] = __builtin_amdgcn_mfma_f32_16x16x32_bf16(kf, vf[bb], St[a][bb], 0, 0, 0); } }
    }
}

struct Args { const float* in[17]; float* out; unsigned char* ws; int ph_lo, ph_hi; };

__global__ void __launch_bounds__(NTHREADS, 2) fwd_kernel(Args args) {
    extern __shared__ __attribute__((aligned(16))) unsigned char lds_raw[];
    LAS unsigned char* lds = (LAS unsigned char*)lds_raw;
    cg::grid_group grid = cg::this_grid();
    const int tid = threadIdx.x, lane = tid & 63, wave = __builtin_amdgcn_readfirstlane(tid >> 6);
    const int G = gridDim.x, bid = blockIdx.x;
    const int gw = bid * NWAVES + wave, NGW = G * NWAVES;
    typedef const __attribute__((address_space(4))) unsigned char* kptr_t;
#define KP_DECL kptr_t kp = (kptr_t)__builtin_amdgcn_kernarg_segment_ptr(); asm volatile("" : "+s"(kp)); unsigned char* ws = *(unsigned char* const __attribute__((address_space(4)))*)(kp + 144); (void)ws
#define KIN(i) (*(const float* const __attribute__((address_space(4)))*)(kp + 8 * (i)))
#define KOUT (*(float* const __attribute__((address_space(4)))*)(kp + 136))
    int lo, hi; { kptr_t kp0 = (kptr_t)__builtin_amdgcn_kernarg_segment_ptr(); lo = *(const int __attribute__((address_space(4)))*)(kp0 + 152); hi = *(const int __attribute__((address_space(4)))*)(kp0 + 156); }
#ifndef PHMASK
#define PHMASK 0x7ff
#endif
#define IN(k) (((PHMASK >> (k)) & 1) && lo <= (k) && (k) < hi)
#define SEAM(k) do { if (IN(k) && IN((k) + 1)) { if ((k) == 0) grid.sync(); else { \
        __builtin_amdgcn_fence(__ATOMIC_RELEASE, "agent"); __syncthreads(); \
        if (threadIdx.x == 0) { unsigned* ctr = (unsigned*)(*(unsigned char* const __attribute__((address_space(4)))*)((kptr_t)__builtin_amdgcn_kernarg_segment_ptr() + 144) + WS_BAR); \
            __hip_atomic_fetch_add(ctr, 1u, __ATOMIC_RELEASE, __HIP_MEMORY_SCOPE_AGENT); const unsigned target = (unsigned)(k) * gridDim.x; \
            while (__hip_atomic_load(ctr, __ATOMIC_ACQUIRE, __HIP_MEMORY_SCOPE_AGENT) < target) __builtin_amdgcn_s_sleep(4); } \
        __syncthreads(); __builtin_amdgcn_fence(__ATOMIC_ACQUIRE, "agent"); } } } while (0)

    if (IN(0)) {
        KP_DECL; const float* cvec = KIN(1); const float* w_ada = KIN(2); const float* w_in = KIN(6); const float* pool_w = KIN(7); const float* w_pp = KIN(14); const float* w_pg = KIN(15); const float* w_out = KIN(16);
        float* adaacc = (float*)(ws + WS_ADA); bf16_t* WIN = (bf16_t*)(ws + WS_WIN); bf16_t* WPP = (bf16_t*)(ws + WS_WPP); bf16_t* WPG = (bf16_t*)(ws + WS_WPG); bf16_t* WOUT = (bf16_t*)(ws + WS_WOUT); bf16_t* POOLW = (bf16_t*)(ws + WS_POOLW);
        for (int it = gw; it < 48 * 16; it += NGW) { const int nc = it % 48, ksl = it / 48; const int n = nc * 64 + lane; float s = 0.f;
#pragma unroll 8
            for (int kk = 0; kk < 64; ++kk) { const int k = ksl * 64 + kk; const float cv = cvec[k]; s += cv * sigmoidf_(cv) * w_ada[(size_t)k * (3 * D) + n]; }
            atomicAdd(adaacc + n, s); }
        LAS float* scr = (LAS float*)(lds + wave * 16384);
        constexpr int I_IN = 16 * 225, I_SQ = 16 * 32, I_PW = 4 * 8;
        constexpr int NIT = I_IN + 3 * I_SQ + 4 * I_PW;
        for (int it = gw; it < NIT; it += NGW) { int r = it;
            if (r < I_IN) { const int kb = r / 225, nb = r % 225; const int drow = nb < 160 ? nb * 32 : (nb == 160 ? NPROJ : (nb - 1) * 32);
                transpose_item(w_in, D, 7200, WIN, kb * 64, nb * 32, drow - 0, scr, lane); continue; } r -= I_IN;
            if (r < 3 * I_SQ) { const int which = r / I_SQ, rr = r % I_SQ; const int kb = rr / 32, nb = rr % 32;
                const float* W = which == 0 ? w_pp : (which == 1 ? w_pg : w_out); bf16_t* WT = which == 0 ? WPP : (which == 1 ? WPG : WOUT);
                transpose_item(W, D, D, WT, kb * 64, nb * 32, nb * 32, scr, lane); continue; } r -= 3 * I_SQ;
            { const int gI = r / I_PW, rr = r % I_PW; const int kb = rr / 8, nb = rr % 8;
              transpose_item(pool_w + (size_t)gI * 65536, 256, 256, POOLW, kb * 64, nb * 32, gI * 256 + nb * 32, scr, lane); }
        }
    }
    SEAM(0);

    if (IN(1)) {
        KP_DECL; const float* x = KIN(0); const float* b_ada = KIN(3); const float* g_pre = KIN(4); const float* adaacc = (const float*)(ws + WS_ADA); const bf16_t* WIN = (const bf16_t*)(ws + WS_WIN); float* LR = (float*)(ws + WS_LR); bf16_t* H = (bf16_t*)KOUT;
        constexpr int HS_PITCH = 2064;
        constexpr int L_HS = 0, L_RED = 16 * HS_PITCH;
        f32x4 gs[4], sh[4];
#pragma unroll
        for (int j = 0; j < 4; ++j) { const int c0 = 4 * lane + 256 * j;
            const f32x4 shv = *(const f32x4*)(adaacc + c0) + *(const f32x4*)(b_ada + c0);
            const f32x4 scv = *(const f32x4*)(adaacc + D + c0) + *(const f32x4*)(b_ada + D + c0);
            gs[j] = *(const f32x4*)(g_pre + c0) * (scv + 1.f); sh[j] = shv; }
        const int fr = lane & 15, fq = lane >> 4;
        bf16x8 bfr[2][4];
#pragma unroll
        for (int nt = 0; nt < 2; ++nt)
#pragma unroll
            for (int kk = 0; kk < 4; ++kk) bfr[nt][kk] = *(const bf16x8*)(WIN + (size_t)(NPROJ + nt * 16 + fr) * D + (4 * wave + kk) * 32 + fq * 8);
        for (int grp = bid; grp < S / 16; grp += G) {
#pragma unroll
            for (int rr = 0; rr < 2; ++rr) { const int rl = 2 * wave + rr; const size_t row = (size_t)grp * 16 + rl;
                const f32x4* xr = (const f32x4*)(x + row * D) + lane; f32x4 v[4]; float s = 0.f;
#pragma unroll
                for (int j = 0; j < 4; ++j) { v[j] = xr[64 * j]; s += (v[j][0] * v[j][0] + v[j][1] * v[j][1]) + (v[j][2] * v[j][2] + v[j][3] * v[j][3]); }
                const float rstd = __builtin_amdgcn_rsqf(wave_sum(s) * (1.f / D) + RMS_EPS);
#pragma unroll
                for (int j = 0; j < 4; ++j) { const f32x4 hv = v[j] * rstd * gs[j] + sh[j]; const u32x2 pk = (u32x2){cvt_pk_bf16(hv[0], hv[1]), cvt_pk_bf16(hv[2], hv[3])};
                    *(u32x2*)(H + row * D + 4 * lane + 256 * j) = pk; *(LAS u32x2*)(lds + L_HS + rl * HS_PITCH + (4 * lane + 256 * j) * 2) = pk; } }
            __syncthreads();
            f32x4 pa[2] = {(f32x4){0.f, 0.f, 0.f, 0.f}, (f32x4){0.f, 0.f, 0.f, 0.f}};
#pragma unroll
            for (int kk = 0; kk < 4; ++kk) { const bf16x8 af = *(const LAS bf16x8*)(lds + L_HS + fr * HS_PITCH + ((4 * wave + kk) * 32 + fq * 8) * 2);
                pa[0] = __builtin_amdgcn_mfma_f32_16x16x32_bf16(af, bfr[0][kk], pa[0], 0, 0, 0); pa[1] = __builtin_amdgcn_mfma_f32_16x16x32_bf16(af, bfr[1][kk], pa[1], 0, 0, 0); }
            *(LAS f32x4*)(lds + L_RED + ((wave * 2 + 0) * 64 + lane) * 16) = pa[0]; *(LAS f32x4*)(lds + L_RED + ((wave * 2 + 1) * 64 + lane) * 16) = pa[1];
            __syncthreads();
            { const int nt = tid >> 8, ll = (tid >> 2) & 63, jj = tid & 3; float s = 0.f;
#pragma unroll
              for (int ww = 0; ww < 8; ++ww) s += *(const LAS float*)(lds + L_RED + ((ww * 2 + nt) * 64 + ll) * 16 + jj * 4);
              LR[((size_t)grp * 16 + (ll >> 4) * 4 + jj) * 32 + nt * 16 + (ll & 15)] = s; }
        }
        __syncthreads();
    }
    SEAM(1);

    if (IN(2)) {
        KP_DECL; const bf16_t* H = (const bf16_t*)KOUT; const bf16_t* WIN = (const bf16_t*)(ws + WS_WIN);
        pg8::Gemm g{H, WIN, S, NPROJ, D, D, 0}; pg8::StaticOrder so; so.init(S, NPROJ, G, bid);
        pg8::EpiProj E{ws};
        pg8::gemm_phase<pg8::EpiProj>(lds, g, so, E);
    }
    SEAM(2);

    if (IN(3)) {
        KP_DECL; const bf16_t* PIN = (const bf16_t*)(ws + WS_PIN); bf16_t* POOLED = (bf16_t*)KOUT;
        for (int it = bid * NTHREADS + tid; it < (S / 16) * 128; it += G * NTHREADS) { const int cc = it & 127, rb = it >> 7; const int r0 = rb * 16, c0 = cc * 8; const int hw = 1 << (c0 >> 8);
            float sum[8];
#pragma unroll
            for (int e = 0; e < 8; ++e) sum[e] = 0.f;
            for (int r = r0 - hw; r < r0 + hw; ++r) if (r >= 0 && r < S) { f32x4 a, b; pg8::unpack8(*(const u32x4*)(PIN + (size_t)r * D + c0), a, b);
#pragma unroll
                for (int e = 0; e < 4; ++e) { sum[e] += a[e]; sum[4 + e] += b[e]; } }
            for (int s = r0; s < r0 + 16; ++s) { const int lo_ = max(s - hw, 0), hi_ = min(s + hw, S); const float inv = 1.f / (float)(hi_ - lo_);
                f32x4 a, b; pg8::unpack8(*(const u32x4*)(PIN + (size_t)s * D + c0), a, b); f32x4 o0, o1;
#pragma unroll
                for (int e = 0; e < 4; ++e) { o0[e] = sum[e] * inv - a[e]; o1[e] = sum[4 + e] * inv - b[e]; }
                *(u32x4*)(POOLED + (size_t)s * D + c0) = pg8::pack8(o0, o1);
                if (s + hw < S) { pg8::unpack8(*(const u32x4*)(PIN + (size_t)(s + hw) * D + c0), a, b);
#pragma unroll
                    for (int e = 0; e < 4; ++e) { sum[e] += a[e]; sum[4 + e] += b[e]; } }
                if (s - hw >= 0) { pg8::unpack8(*(const u32x4*)(PIN + (size_t)(s - hw) * D + c0), a, b);
#pragma unroll
                    for (int e = 0; e < 4; ++e) { sum[e] -= a[e]; sum[4 + e] -= b[e]; } } }
        }
    }
    SEAM(3);

    if (IN(4)) {
        KP_DECL; const float* pool_scale = KIN(8); const bf16_t* POOLED = (const bf16_t*)KOUT; bf16_t* A2 = (bf16_t*)((unsigned char*)KOUT + 32 * MiB); const bf16_t* POOLW = (const bf16_t*)(ws + WS_POOLW); const bf16_t* SPG = (const bf16_t*)(ws + WS_SPG);
        pg8::Gemm g{POOLED, POOLW, S, D, 256, D, 256}; pg8::StaticOrder so; so.init(S, D, G, bid);
        pg8::EpiPool E{SPG, A2, pool_scale};
        pg8::gemm_phase<pg8::EpiPool>(lds, g, so, E);
    }
    SEAM(4);

    if (IN(5)) {
        KP_DECL; const float* gk_up_f = KIN(9); const float* gk_bias_f = KIN(10); const float* gk_up_b = KIN(11); const float* gk_bias_b = KIN(12);
        const bf16_t* A2 = (const bf16_t*)((unsigned char*)KOUT + 32 * MiB); const bf16_t* WPP = (const bf16_t*)(ws + WS_WPP); bf16_t* SBP = (bf16_t*)(ws + WS_SBP);
        const bf16_t* Qb = (const bf16_t*)(ws + WS_Q); const bf16_t* Kb = (const bf16_t*)(ws + WS_K); const bf16_t* Vb = (const bf16_t*)(ws + WS_V); const float* LR = (const float*)(ws + WS_LR); float* LTOT = (float*)(ws + WS_LTOT); float* STATES = (float*)(ws + WS_STATES);
        { pg8::Gemm g{A2, WPP, S, D, D, D, 0}; pg8::StaticOrder so; so.init(S, D, G, bid);
          pg8::EpiYPool E{SBP};
          pg8::gemm_phase<pg8::EpiYPool>(lds, g, so, E); }
        for (int item = bid; item < NSC * NH * 2; item += G) { const int dir = item & 1, h = (item >> 1) & 3, sc = item >> 3;
            int tl = tid; asm volatile("" : "+v"(tl));
            const int d = tl & 127; const float* upp = dir ? gk_up_b : gk_up_f; const float* bp = dir ? gk_bias_b : gk_bias_f;
            __syncthreads();
#pragma unroll
            for (int m = 0; m < 4; ++m) ((LAS float*)(lds + L_UP))[(m * 4 + (tl >> 7)) * 128 + d] = upp[(m * 4 + (tl >> 7)) * KW + h * HK + d];
            const float bias = bp[h * HK + d];
            f32x4 St[8][2];
#pragma unroll
            for (int a = 0; a < 8; ++a) { St[a][0] = (f32x4){0.f, 0.f, 0.f, 0.f}; St[a][1] = (f32x4){0.f, 0.f, 0.f, 0.f}; }
            float ltot = 0.f;
            for (int cc = 0; cc < SCN; ++cc) { const int c = dir ? (SCN - 1 - cc) : cc; const int row0 = (sc * SCN + c) * CH;
                gla_chunk<false>(lds, tl, row0, h, dir, Qb, Kb, Vb, LR, bias, St, ltot, nullptr, nullptr, nullptr); }
            float* sp = STATES + ((size_t)(dir * NSC + sc) * NH + h) * (HK * HV);
            const int fr = tl & 15, fq = (tl & 63) >> 4; const unsigned so = (unsigned)((fq * 4) * HV + (2 * wave) * 16 + fr);
#pragma unroll
            for (int a = 0; a < 8; ++a) { unsigned soa = so + (unsigned)(a * 16 * HV); asm volatile("" : "+v"(soa));
#pragma unroll
                for (int bb = 0; bb < 2; ++bb)
#pragma unroll
                    for (int jj = 0; jj < 4; ++jj) sp[soa + (unsigned)(jj * HV + bb * 16)] = St[a][bb][jj];
                __builtin_amdgcn_sched_barrier(0); }
            if (tl < 128) LTOT[((size_t)(dir * NSC + sc) * NH + h) * HK + tl] = ltot;
        }
    }
    SEAM(5);

    if (IN(6)) {
        KP_DECL; const float* LTOT = (const float*)(ws + WS_LTOT); float* STATES = (float*)(ws + WS_STATES);
        for (int e = bid * NTHREADS + tid; e < 2 * NH * HK * HV; e += G * NTHREADS) { const int dir = e / (NH * HK * HV), rem = e % (NH * HK * HV), h = rem / (HK * HV), idx = rem % (HK * HV), dk = idx / HV;
            float carry = 0.f;
            for (int i = 0; i < NSC; ++i) { const int sc = dir ? (NSC - 1 - i) : i; const size_t o = ((size_t)(dir * NSC + sc) * NH + h);
                float* p = STATES + o * (HK * HV) + idx; const float t = *p; *p = carry; carry = __expf(LTOT[o * HK + dk]) * carry + t; }
        }
    }
    SEAM(6);

    if (IN(7)) {
        KP_DECL; const float* gk_up_f = KIN(9); const float* gk_bias_f = KIN(10); const float* gk_up_b = KIN(11); const float* gk_bias_b = KIN(12); const float* gla_norm_g = KIN(13);
        const bf16_t* Qb = (const bf16_t*)(ws + WS_Q); const bf16_t* Kb = (const bf16_t*)(ws + WS_K); const bf16_t* Vb = (const bf16_t*)(ws + WS_V); const float* LR = (const float*)(ws + WS_LR); const float* STATES = (const float*)(ws + WS_STATES);
        bf16_t* SGG = (bf16_t*)(ws + WS_SGG); float* OF = KOUT;
        for (int item = bid; item < NSC * NH; item += G) { const int h = item & 3, sc = item >> 2;
            int tl = tid; asm volatile("" : "+v"(tl));
            const int d = tl & 127, fr = tl & 15, fq = (tl & 63) >> 4;
            for (int dir = 0; dir < 2; ++dir) {
                const float* upp = dir ? gk_up_b : gk_up_f; const float* bp = dir ? gk_bias_b : gk_bias_f;
                __syncthreads();
#pragma unroll
                for (int m = 0; m < 4; ++m) ((LAS float*)(lds + L_UP))[(m * 4 + (tl >> 7)) * 128 + d] = upp[(m * 4 + (tl >> 7)) * KW + h * HK + d];
                const float bias = bp[h * HK + d];
                const float* sp = STATES + ((size_t)(dir * NSC + sc) * NH + h) * (HK * HV);
                const unsigned so = (unsigned)((fq * 4) * HV + (2 * wave) * 16 + fr);
                f32x4 St[8][2];
#pragma unroll
                for (int a = 0; a < 8; ++a) { unsigned soa = so + (unsigned)(a * 16 * HV); asm volatile("" : "+v"(soa));
#pragma unroll
                    for (int bb = 0; bb < 2; ++bb)
#pragma unroll
                        for (int jj = 0; jj < 4; ++jj) St[a][bb][jj] = sp[soa + (unsigned)(jj * HV + bb * 16)];
                    __builtin_amdgcn_sched_barrier(0); }
                float ltot = 0.f;
                for (int cc = 0; cc < SCN; ++cc) { const int c = dir ? (SCN - 1 - cc) : cc; const int row0 = (sc * SCN + c) * CH;
                    gla_chunk<true>(lds, tl, row0, h, dir, Qb, Kb, Vb, LR, bias, St, ltot, OF, SGG, gla_norm_g); }
            }
        }
    }
    SEAM(7);

    if (IN(8)) {
        KP_DECL; const bf16_t* SGG = (const bf16_t*)(ws + WS_SGG); const bf16_t* WPG = (const bf16_t*)(ws + WS_WPG); const bf16_t* SBP = (const bf16_t*)(ws + WS_SBP); bf16_t* SBG = (bf16_t*)(ws + WS_SBG);
        pg8::Gemm g{SGG, WPG, S, D, D, D, 0}; pg8::StaticOrder so; so.init(S, D, G, bid);
        pg8::EpiYGla E{SBP, SBG};
        pg8::gemm_phase<pg8::EpiYGla>(lds, g, so, E);
    }
    SEAM(8);

    if (IN(9)) {
        KP_DECL; const bf16_t* SBG = (const bf16_t*)(ws + WS_SBG); const bf16_t* WOUT = (const bf16_t*)(ws + WS_WOUT); float* OUT = KOUT; float* rowsq = (float*)(ws + WS_ROWSQ);
        pg8::Gemm g{SBG, WOUT, S, D, D, D, 0}; pg8::StaticOrder so; so.init(S, D, G, bid);
        pg8::EpiOut E{OUT, rowsq};
        pg8::gemm_phase<pg8::EpiOut>(lds, g, so, E);
    }
    SEAM(9);

    if (IN(10)) {
        KP_DECL; const float* x = KIN(0); const float* b_ada = KIN(3); const float* g_post = KIN(5); const float* adaacc = (const float*)(ws + WS_ADA); const float* rowsq = (const float*)(ws + WS_ROWSQ); float* OUT = KOUT;
        for (size_t i4 = (size_t)bid * NTHREADS + tid; i4 < (size_t)S * D / 4; i4 += (size_t)G * NTHREADS) { const int row = (int)(i4 >> 8), c0 = (int)(i4 & 255) * 4;
            const float rstd = __builtin_amdgcn_rsqf(rowsq[row] * (1.f / D) + RMS_EPS);
            const f32x4 gate = *(const f32x4*)(adaacc + 2 * D + c0) + *(const f32x4*)(b_ada + 2 * D + c0);
            const f32x4 gp = *(const f32x4*)(g_post + c0); const f32x4 ov = *(const f32x4*)(OUT + i4 * 4); const f32x4 xv = *(const f32x4*)(x + i4 * 4);
            *(f32x4*)(OUT + i4 * 4) = xv + gate * (ov * rstd * gp); }
    }
#undef IN
#undef SEAM
}

constexpr int NPHASES = 11;
extern "C" void kernel_launch(void* const* d_in, const int* in_sizes, int n_in, void* d_out, int out_size, void* d_ws, size_t ws_size, hipStream_t stream) {
    static int grid = 0;
    if (grid == 0) {
        if (n_in != 17 || out_size != S * D || ws_size < WS_END) { fprintf(stderr, "kernel_launch: unexpected problem shape (n_in %d out %d ws %zu)\n", n_in, out_size, ws_size); grid = -1; return; }
        int dev = 0, cus = 0, per_cu = 0;
        hipGetDevice(&dev); hipDeviceGetAttribute(&cus, hipDeviceAttributeMultiprocessorCount, dev);
        if (hipFuncSetAttribute((const void*)fwd_kernel, hipFuncAttributeMaxDynamicSharedMemorySize, LDS_BYTES) != hipSuccess) { fprintf(stderr, "kernel_launch: hipFuncSetAttribute failed\n"); grid = -1; return; }
        if (hipOccupancyMaxActiveBlocksPerMultiprocessor(&per_cu, (const void*)fwd_kernel, NTHREADS, LDS_BYTES) != hipSuccess || per_cu < 1) { fprintf(stderr, "kernel_launch: occupancy query says %d\n", per_cu); per_cu = 1; (void)hipGetLastError(); }
        grid = cus * 1;
        if (grid > cus * per_cu) grid = cus * per_cu;
    }
    if (grid < 0) return;
    hipMemsetAsync((char*)d_ws + WS_CTL, 0, CTL_ZERO_BYTES, stream);
    Args a{};
    for (int i = 0; i < 17; ++i) a.in[i] = (const float*)d_in[i];
    a.out = (float*)d_out; a.ws = (unsigned char*)d_ws;
#if ONE_LAUNCH
    a.ph_lo = 0; a.ph_hi = NPHASES;
    void* kargs[] = {&a};
    hipError_t e = hipLaunchCooperativeKernel((const void*)fwd_kernel, dim3(grid), dim3(NTHREADS), kargs, LDS_BYTES, stream);
    if (e != hipSuccess) fprintf(stderr, "cooperative launch failed: %s (grid %d)\n", hipGetErrorString(e), grid);
#else
    for (int p = 0; p < NPHASES; ++p) { a.ph_lo = p; a.ph_hi = p + 1;
        hipLaunchKernelGGL(fwd_kernel, dim3(grid), dim3(NTHREADS), LDS_BYTES, stream, a); }
#endif
}
```

```cpp
#include <hip/hip_runtime.h>
#include <hip/hip_cooperative_groups.h>
#include <cstdio>
#include <cstdint>
namespace cg = cooperative_groups;

#ifndef ONE_LAUNCH
#define ONE_LAUNCH 1
#endif

#define LAS __attribute__((address_space(3)))
typedef unsigned short bf16_t;
typedef short bf16x8 __attribute__((ext_vector_type(8)));
typedef float f32x4 __attribute__((ext_vector_type(4)));
typedef unsigned u32x4 __attribute__((ext_vector_type(4)));
typedef unsigned u32x2 __attribute__((ext_vector_type(2)));

constexpr int S = 16384, D = 1024, NPROJ = 7168, KW = 512, HK = 128, HV = 256, NH = 4, RANK = 16;
constexpr int CH = 64, SCN = 4, NSC = S / (CH * SCN);
constexpr float RMS_EPS = 1e-6f;
constexpr int NTHREADS = 512, NWAVES = 8;
constexpr int LDS_BYTES = 135168;

constexpr size_t MiB = 1u << 20;
constexpr size_t WS_CTL = 0, CTL_ZERO_BYTES = 128 * 1024;
constexpr size_t WS_ADA = 0, WS_ROWSQ = 16 * 1024, WS_BAR = 96 * 1024;
constexpr size_t WS_WIN = 1 * MiB;
constexpr size_t WS_WPP = 16 * MiB, WS_WPG = 18 * MiB, WS_WOUT = 20 * MiB, WS_POOLW = 22 * MiB;
constexpr size_t WS_LR = 23 * MiB;
constexpr size_t WS_LTOT = 25 * MiB;
constexpr size_t WS_PIN = 26 * MiB, WS_SPG = 58 * MiB, WS_Q = 90 * MiB, WS_K = 106 * MiB, WS_V = 122 * MiB, WS_SGG = 154 * MiB, WS_SBP = 186 * MiB, WS_SBG = 218 * MiB;
constexpr size_t WS_STATES = 26 * MiB;
constexpr size_t WS_END = 250 * MiB;

__device__ __forceinline__ unsigned cvt_pk_bf16(float lo, float hi) { unsigned r; asm volatile("v_cvt_pk_bf16_f32 %0, %1, %2" : "=v"(r) : "v"(lo), "v"(hi)); return r; }
__device__ __forceinline__ float bflo(unsigned u) { return __builtin_bit_cast(float, u << 16); }
__device__ __forceinline__ float bfhi(unsigned u) { return __builtin_bit_cast(float, u & 0xffff0000u); }
__device__ __forceinline__ float bf1(bf16_t u) { return __builtin_bit_cast(float, (unsigned)u << 16); }
__device__ __forceinline__ float sigmoidf_(float x) { return __builtin_amdgcn_rcpf(1.f + __expf(-x)); }
__device__ __forceinline__ float wave_sum(float v) {
#pragma unroll
    for (int o = 1; o < 64; o <<= 1) v += __shfl_xor(v, o);
    return v;
}

namespace pg8 {
constexpr int BM = 256, BK = 64, HALF = 128, HTB = HALF * BK * 2, NXCD = 8, WGM = 8;
__host__ __device__ __forceinline__ int lds_byte(int r, int c) { const int st = (r >> 4) * 2 + (c >> 5), rr = r & 15, cc = c & 31, ob = rr * 64 + cc * 2; return st * 1024 + (ob ^ (((ob >> 9) & 1) << 5)); }
__host__ __device__ __forceinline__ void stage_rc(int b, int& R, int& C) { const int st = b / 1024, sb = b % 1024, swz = sb ^ (((sb >> 9) & 1) << 5); R = (st >> 1) * 16 + swz / 64; C = (st & 1) * 32 + (swz % 64) / 2; }
__host__ __device__ __forceinline__ int perm32(int rho) { const int n = rho >> 4, i = rho & 15; return 8 * (i >> 2) + 4 * n + (i & 3); }

struct Unit { int pm, pn; };
struct Gemm { const bf16_t* A; const bf16_t* Bt; int M, N, K, lda, a_pn_off; };

struct StaticOrder {
    int nM, nN, nwg, G, c;
    __device__ void init(int M, int N, int G_, int c_) { nM = M / BM; nN = N / BM; nwg = nM * nN; G = G_; c = c_; }
    __device__ bool next(int i, Unit& u) const {
        const long L = (long)i * G + c; if (L >= nwg) return false;
        int wgid = (int)L; { const int q = nwg / NXCD, r = nwg % NXCD, xcd = wgid % NXCD, off = wgid / NXCD; wgid = (xcd < r ? xcd * (q + 1) : r * (q + 1) + (xcd - r) * q) + off; }
        const int nig = WGM * nN, gid = wgid / nig, fm = gid * WGM, gsz = (nM - fm) < WGM ? (nM - fm) : WGM;
        u.pm = fm + ((wgid % nig) % gsz); u.pn = (wgid % nig) / gsz; return true;
    }
};

template <class Epi>
__device__ __forceinline__ void gemm_phase(LAS unsigned char* lds, const Gemm g, const StaticOrder& S, const Epi& E) {
    const int tid = threadIdx.x, wid = __builtin_amdgcn_readfirstlane(tid >> 6), lane = tid & 63, wr = wid >> 2, wc = wid & 3, fr = lane & 15, fq = lane >> 4;
    const int K = g.K, nt = K / BK, lda = g.lda;
    unsigned voffA[2], voffB[2];
#pragma unroll
    for (int i = 0; i < 2; ++i) { int R, C; stage_rc(tid * 16 + i * 8192, R, C); const int Rb = (R & ~31) + perm32(R & 31);
        voffA[i] = (unsigned)(R * lda + C) * 2u; voffB[i] = (unsigned)(Rb * K + C) * 2u; }
    const size_t kstep = (size_t)(BK * 2);
    const size_t hstepA = (size_t)HALF * lda * 2, hstepB = (size_t)HALF * K * 2;
    const size_t tstepA = 2 * hstepA, tstepB = 2 * hstepB;
    const unsigned ldsw = (unsigned)wid * 1024u;
    const int aoff = lds_byte(wr * 64 + fr, fq * 8), boff = lds_byte(wc * 32 + fr, fq * 8);
#define PG8_SA(b, h) (((b) * 2 + (h)) * HTB)
#define PG8_SB(b, h) ((4 + (b) * 2 + (h)) * HTB)
#define PG8_STAGE(bufoff, gbase, voff) do { _Pragma("unroll") for (int _i = 0; _i < 2; ++_i) \
        __builtin_amdgcn_global_load_lds((const unsigned*)((const char*)(gbase) + (voff)[_i]), (LAS unsigned*)(lds + (bufoff) + ldsw + _i * 8192), 16, 0, 0); } while (0)
#define PG8_LDA(dst, b, h) do { _Pragma("unroll") for (int m = 0; m < 4; ++m) _Pragma("unroll") for (int k = 0; k < 2; ++k) dst[m][k] = *(const LAS bf16x8*)(lds + PG8_SA(b, h) + aoff + m * 2048 + k * 1024); } while (0)
#define PG8_LDB(dst, b, h) do { _Pragma("unroll") for (int n = 0; n < 2; ++n) _Pragma("unroll") for (int k = 0; k < 2; ++k) dst[n][k] = *(const LAS bf16x8*)(lds + PG8_SB(b, h) + boff + n * 2048 + k * 1024); } while (0)
#define PG8_MMA(ai, bj, At, Bt) do { __builtin_amdgcn_s_setprio(1); _Pragma("unroll") for (int m = 0; m < 4; ++m) _Pragma("unroll") for (int n = 0; n < 2; ++n) _Pragma("unroll") for (int k = 0; k < 2; ++k) \
        acc[ai][bj][m][n] = __builtin_amdgcn_mfma_f32_16x16x32_bf16(Bt[n][k], At[m][k], acc[ai][bj][m][n], 0, 0, 0); __builtin_amdgcn_s_setprio(0); } while (0)
#define PG8_WAIT_V(n) asm volatile("s_waitcnt vmcnt(" #n ")" ::: "memory")
#define PG8_WAIT_L(n) asm volatile("s_waitcnt lgkmcnt(" #n ")" ::: "memory")
#define PG8_BAR __builtin_amdgcn_s_barrier()
#define PG8_SCHED __builtin_amdgcn_sched_barrier(0)
    Unit cur, nxt; int ui = 0;
    if (!S.next(0, cur)) return;
    f32x4 acc[2][2][4][2];
#pragma unroll
    for (int a = 0; a < 2; ++a)
#pragma unroll
        for (int b = 0; b < 2; ++b)
#pragma unroll
            for (int m = 0; m < 4; ++m)
#pragma unroll
                for (int n = 0; n < 2; ++n) acc[a][b][m][n] = (f32x4){0.f, 0.f, 0.f, 0.f};
    bf16x8 At[4][2], B0[2][2], B1[2][2];
    const char* cA = (const char*)g.A + (size_t)cur.pm * tstepA + (size_t)cur.pn * g.a_pn_off * 2; const char* cB = (const char*)g.Bt + (size_t)cur.pn * tstepB;
    PG8_STAGE(PG8_SB(0, 0), cB, voffB); PG8_STAGE(PG8_SB(0, 1), cB + hstepB, voffB); PG8_STAGE(PG8_SA(0, 0), cA, voffA); PG8_STAGE(PG8_SA(0, 1), cA + hstepA, voffA);
    if (wr == 1) PG8_BAR;
    PG8_WAIT_V(2); PG8_BAR;
    PG8_STAGE(PG8_SB(1, 0), cB + kstep, voffB); PG8_STAGE(PG8_SA(1, 0), cA + kstep, voffA); PG8_STAGE(PG8_SB(1, 1), cB + hstepB + kstep, voffB);
    PG8_WAIT_V(6); PG8_BAR;
    for (;;) {
        const bool has_next = S.next(ui + 1, nxt);
        const char* nA = has_next ? (const char*)g.A + (size_t)nxt.pm * tstepA + (size_t)nxt.pn * g.a_pn_off * 2 : cA; const char* nB = has_next ? (const char*)g.Bt + (size_t)nxt.pn * tstepB : cB;
        for (int t = 0; t < nt; t += 2) {
            const bool last = (t == nt - 2);
            const char* a1 = cA + (size_t)(t + 1) * kstep;
            const char* a2 = last ? nA : cA + (size_t)(t + 2) * kstep; const char* b2 = last ? nB : cB + (size_t)(t + 2) * kstep;
            const char* a3 = a2 + kstep; const char* b3 = b2 + kstep;
            PG8_LDB(B0, 0, 0); PG8_LDB(B1, 0, 1); PG8_SCHED; PG8_LDA(At, 0, 0); PG8_STAGE(PG8_SA(1, 1), a1 + hstepA, voffA);
            PG8_WAIT_V(8); PG8_WAIT_L(0); PG8_BAR; PG8_MMA(0, 0, At, B0); PG8_MMA(0, 1, At, B1); PG8_BAR; PG8_SCHED;
            PG8_LDA(At, 0, 1); PG8_STAGE(PG8_SB(0, 0), b2, voffB); PG8_STAGE(PG8_SB(0, 1), b2 + hstepB, voffB); PG8_STAGE(PG8_SA(0, 0), a2, voffA);
            PG8_WAIT_V(8); PG8_WAIT_L(0); PG8_BAR; PG8_MMA(1, 0, At, B0); PG8_MMA(1, 1, At, B1); PG8_BAR; PG8_SCHED;
            PG8_LDB(B0, 1, 0); PG8_LDB(B1, 1, 1); PG8_SCHED; PG8_LDA(At, 1, 0); PG8_STAGE(PG8_SA(0, 1), a2 + hstepA, voffA);
            PG8_WAIT_V(8); PG8_WAIT_L(0); PG8_BAR; PG8_MMA(0, 0, At, B0); PG8_MMA(0, 1, At, B1); PG8_BAR; PG8_SCHED;
            PG8_LDA(At, 1, 1); PG8_STAGE(PG8_SB(1, 0), b3, voffB); PG8_STAGE(PG8_SB(1, 1), b3 + hstepB, voffB); PG8_STAGE(PG8_SA(1, 0), a3, voffA);
            PG8_WAIT_V(8); PG8_WAIT_L(0); PG8_BAR; PG8_MMA(1, 0, At, B0); PG8_MMA(1, 1, At, B1); PG8_BAR; PG8_SCHED;
        }
        if (wr == 0) PG8_BAR;
        E(acc, cur, wr, wc, fr, fq);
        if (!has_next) break;
#pragma unroll
        for (int a = 0; a < 2; ++a)
#pragma unroll
            for (int b = 0; b < 2; ++b)
#pragma unroll
                for (int m = 0; m < 4; ++m)
#pragma unroll
                    for (int n = 0; n < 2; ++n) acc[a][b][m][n] = (f32x4){0.f, 0.f, 0.f, 0.f};
        cur = nxt; cA = nA; cB = nB; ++ui;
        if (wr == 1) PG8_BAR;
    }
    PG8_WAIT_V(0);
    PG8_BAR;
#undef PG8_SA
#undef PG8_SB
#undef PG8_STAGE
#undef PG8_LDA
#undef PG8_LDB
#undef PG8_MMA
#undef PG8_WAIT_V
#undef PG8_WAIT_L
#undef PG8_BAR
#undef PG8_SCHED
}

__device__ __forceinline__ u32x4 pack8(f32x4 v0, f32x4 v1) { u32x4 w; w.x = cvt_pk_bf16(v0[0], v0[1]); w.y = cvt_pk_bf16(v0[2], v0[3]); w.z = cvt_pk_bf16(v1[0], v1[1]); w.w = cvt_pk_bf16(v1[2], v1[3]); return w; }
__device__ __forceinline__ void unpack8(u32x4 w, f32x4& v0, f32x4& v1) { v0 = (f32x4){bflo(w.x), bfhi(w.x), bflo(w.y), bfhi(w.y)}; v1 = (f32x4){bflo(w.z), bfhi(w.z), bflo(w.w), bfhi(w.w)}; }

struct EpiProj {
    unsigned char* ws;
    __device__ __forceinline__ void operator()(const f32x4 (&acc)[2][2][4][2], const Unit& u, int wr, int wc, int fr, int fq) const {
        const int t = u.pn; size_t off; int pitch, colt, act; float sc = 1.f;
        if (t < 4)       { off = WS_PIN; pitch = D;  colt = t * 256;        act = 0; }
        else if (t < 8)  { off = WS_SPG; pitch = D;  colt = (t - 4) * 256;  act = 1; }
        else if (t < 10) { off = WS_Q;   pitch = KW; colt = (t - 8) * 256;  act = 0; sc = 0.08838834764831845f; }
        else if (t < 12) { off = WS_K;   pitch = KW; colt = (t - 10) * 256; act = 0; }
        else if (t < 16) { off = WS_V;   pitch = D;  colt = (t - 12) * 256; act = 0; }
        else if (t < 20) { off = WS_SGG; pitch = D;  colt = (t - 16) * 256; act = 1; }
        else if (t < 24) { off = WS_SBP; pitch = D;  colt = (t - 20) * 256; act = 2; }
        else             { off = WS_SBG; pitch = D;  colt = (t - 24) * 256; act = 2; }
        bf16_t* base = (bf16_t*)(ws + off);
        const int row0 = u.pm * BM + wr * 64 + fr, col0 = colt + wc * 32 + 8 * fq;
#pragma unroll
        for (int ai = 0; ai < 2; ++ai)
#pragma unroll
            for (int m = 0; m < 4; ++m) { bf16_t* rowp = base + (size_t)(row0 + ai * HALF + m * 16) * pitch + col0;
#pragma unroll
                for (int bj = 0; bj < 2; ++bj) { f32x4 v0 = acc[ai][bj][m][0], v1 = acc[ai][bj][m][1];
                    if (act == 1) {
#pragma unroll
                        for (int e = 0; e < 4; ++e) { v0[e] = v0[e] * sigmoidf_(v0[e]); v1[e] = v1[e] * sigmoidf_(v1[e]); }
                    } else if (act == 2) {
#pragma unroll
                        for (int e = 0; e < 4; ++e) { v0[e] = sigmoidf_(v0[e]); v1[e] = sigmoidf_(v1[e]); }
                    } else { v0 = v0 * sc; v1 = v1 * sc; }
                    *(u32x4*)(rowp + bj * HALF) = pack8(v0, v1); } }
    }
};
struct EpiPool {
    const bf16_t* spg; bf16_t* a2; const float* pscale;
    __device__ __forceinline__ void operator()(const f32x4 (&acc)[2][2][4][2], const Unit& u, int wr, int wc, int fr, int fq) const {
        const int row0 = u.pm * BM + wr * 64 + fr, col0 = u.pn * BM + wc * 32 + 8 * fq;
        f32x4 ps[2][2];
#pragma unroll
        for (int bj = 0; bj < 2; ++bj) { ps[bj][0] = *(const f32x4*)(pscale + col0 + bj * HALF); ps[bj][1] = *(const f32x4*)(pscale + col0 + bj * HALF + 4); }
#pragma unroll
        for (int ai = 0; ai < 2; ++ai)
#pragma unroll
            for (int m = 0; m < 4; ++m) { const size_t ro = (size_t)(row0 + ai * HALF + m * 16) * D + col0;
#pragma unroll
                for (int bj = 0; bj < 2; ++bj) { f32x4 g0, g1; unpack8(*(const u32x4*)(spg + ro + bj * HALF), g0, g1);
                    f32x4 v0 = acc[ai][bj][m][0] * ps[bj][0] * g0, v1 = acc[ai][bj][m][1] * ps[bj][1] * g1;
                    *(u32x4*)(a2 + ro + bj * HALF) = pack8(v0, v1); } }
    }
};
struct EpiYPool {
    bf16_t* sbp;
    __device__ __forceinline__ void operator()(const f32x4 (&acc)[2][2][4][2], const Unit& u, int wr, int wc, int fr, int fq) const {
        const int row0 = u.pm * BM + wr * 64 + fr, col0 = u.pn * BM + wc * 32 + 8 * fq;
#pragma unroll
        for (int ai = 0; ai < 2; ++ai)
#pragma unroll
            for (int m = 0; m < 4; ++m) { const size_t ro = (size_t)(row0 + ai * HALF + m * 16) * D + col0;
#pragma unroll
                for (int bj = 0; bj < 2; ++bj) { f32x4 g0, g1; unpack8(*(const u32x4*)(sbp + ro + bj * HALF), g0, g1);
                    *(u32x4*)(sbp + ro + bj * HALF) = pack8(acc[ai][bj][m][0] * g0, acc[ai][bj][m][1] * g1); } }
    }
};
struct EpiYGla {
    const bf16_t* sbp; bf16_t* sbg;
    __device__ __forceinline__ void operator()(const f32x4 (&acc)[2][2][4][2], const Unit& u, int wr, int wc, int fr, int fq) const {
        const int row0 = u.pm * BM + wr * 64 + fr, col0 = u.pn * BM + wc * 32 + 8 * fq;
#pragma unroll
        for (int ai = 0; ai < 2; ++ai)
#pragma unroll
            for (int m = 0; m < 4; ++m) { const size_t ro = (size_t)(row0 + ai * HALF + m * 16) * D + col0;
#pragma unroll
                for (int bj = 0; bj < 2; ++bj) { f32x4 g0, g1, p0, p1; unpack8(*(const u32x4*)(sbg + ro + bj * HALF), g0, g1); unpack8(*(const u32x4*)(sbp + ro + bj * HALF), p0, p1);
                    *(u32x4*)(sbg + ro + bj * HALF) = pack8(p0 + acc[ai][bj][m][0] * g0, p1 + acc[ai][bj][m][1] * g1); } }
    }
};
struct EpiOut {
    float* out; float* rowsq;
    __device__ __forceinline__ void operator()(const f32x4 (&acc)[2][2][4][2], const Unit& u, int wr, int wc, int fr, int fq) const {
        const int row0 = u.pm * BM + wr * 64 + fr, col0 = u.pn * BM + wc * 32 + 8 * fq;
#pragma unroll
        for (int ai = 0; ai < 2; ++ai)
#pragma unroll
            for (int m = 0; m < 4; ++m) { const int row = row0 + ai * HALF + m * 16; float* rowp = out + (size_t)row * D + col0; float ss = 0.f;
#pragma unroll
                for (int bj = 0; bj < 2; ++bj) { const f32x4 v0 = acc[ai][bj][m][0], v1 = acc[ai][bj][m][1];
                    *(f32x4*)(rowp + bj * HALF) = v0; *(f32x4*)(rowp + bj * HALF + 4) = v1;
                    ss += (v0[0] * v0[0] + v0[1] * v0[1]) + (v0[2] * v0[2] + v0[3] * v0[3]) + (v1[0] * v1[0] + v1[1] * v1[1]) + (v1[2] * v1[2] + v1[3] * v1[3]); }
                ss += __shfl_xor(ss, 16); ss += __shfl_xor(ss, 32);
                if (fq == 0) atomicAdd(rowsq + row, ss); }
    }
};
}

__device__ __forceinline__ void transpose_item(const float* W, int K, int N, bf16_t* WT, int k0, int n0, int drow, LAS float* scr, int lane) {
#pragma unroll 8
    for (int i = 0; i < 32; ++i) { const int kk = 2 * i + (lane >> 5); scr[kk * 33 + (lane & 31)] = W[(size_t)(k0 + kk) * N + n0 + (lane & 31)]; }
    asm volatile("s_waitcnt lgkmcnt(0)" ::: "memory");
    const int c = lane & 7;
#pragma unroll
    for (int j = 0; j < 4; ++j) { const int n = (lane >> 3) + 8 * j; const LAS float* s = scr + (8 * c) * 33 + n;
        u32x4 o; o.x = cvt_pk_bf16(s[0 * 33], s[1 * 33]); o.y = cvt_pk_bf16(s[2 * 33], s[3 * 33]); o.z = cvt_pk_bf16(s[4 * 33], s[5 * 33]); o.w = cvt_pk_bf16(s[6 * 33], s[7 * 33]);
        *(u32x4*)(WT + (size_t)(drow + n) * K + k0 + 8 * c) = o; }
    asm volatile("s_waitcnt lgkmcnt(0)" ::: "memory");
}

constexpr int P_QD = 272, P_T = 144;
constexpr int L_QD = 0, L_KI = L_QD + 64 * P_QD, L_KET = L_KI + 64 * P_QD, L_VT = L_KET + 128 * P_T, L_SC = L_VT + 256 * P_T, L_DEC = L_SC + 64 * P_T,
              L_SEG = L_DEC + 512, L_LR = L_SEG + 2048, L_RS = L_LR + 8192, L_UP = L_RS + 2048, L_GLA_END = L_UP + 8192;
static_assert(L_GLA_END <= LDS_BYTES - 64, "GLA LDS map");

template <bool NEED_O>
__device__ __forceinline__ void gla_chunk(LAS unsigned char* lds, const int tid_in, const int row0, const int h, const int dir,
        const bf16_t* __restrict__ Qb, const bf16_t* __restrict__ Kb, const bf16_t* __restrict__ Vb, const float* __restrict__ LR,
        const float bias, f32x4 (&St)[8][2], float& ltot,
        float* OF, bf16_t* SGG, const float* __restrict__ gnorm) {
    int tid = tid_in; asm volatile("" : "+v"(tid));
    const int w = __builtin_amdgcn_readfirstlane(tid >> 6);
    const int d = tid & 127, seg = tid >> 7;
    __syncthreads();
    ((LAS f32x4*)(lds + L_LR))[tid] = ((const f32x4*)(LR + (size_t)row0 * 32))[tid];
    {
        const int dv = tid & 255, half = tid >> 8;
        const bf16_t* vp = Vb + (size_t)(row0 + half * 32) * D + h * HV + dv;
        unsigned pk[16];
#pragma unroll
        for (int r = 0; r < 16; ++r) { const unsigned lo = vp[(size_t)(2 * r) * D], hi = vp[(size_t)(2 * r + 1) * D]; pk[r] = lo | (hi << 16); }
        LAS unsigned char* vt = lds + L_VT + dv * P_T + half * 64;
#pragma unroll
        for (int q = 0; q < 4; ++q) *(LAS u32x4*)(vt + q * 16) = (u32x4){pk[4 * q], pk[4 * q + 1], pk[4 * q + 2], pk[4 * q + 3]};
    }
    __syncthreads();
    float arr[16];
    {
        const LAS float* upl = (const LAS float*)(lds + L_UP) + d;
        float up[16];
#pragma unroll
        for (int m = 0; m < 16; ++m) up[m] = upl[m * 128];
        const LAS f32x4* lp = (const LAS f32x4*)(lds + L_LR + (seg * 16 * 32 + dir * 16) * 4);
#pragma unroll
        for (int r = 0; r < 16; ++r) {
            float z = bias;
#pragma unroll
            for (int q = 0; q < 4; ++q) { const f32x4 l4 = lp[r * 8 + q]; z += l4[0] * up[4 * q] + l4[1] * up[4 * q + 1] + l4[2] * up[4 * q + 2] + l4[3] * up[4 * q + 3]; }
            arr[r] = (fminf(z, 0.f) - __logf(1.f + __expf(-fabsf(z)))) * (1.f / 16.f);
        }
    }
    if (dir == 0) {
#pragma unroll
        for (int r = 1; r < 16; ++r) arr[r] += arr[r - 1];
    } else {
#pragma unroll
        for (int r = 14; r >= 0; --r) arr[r] += arr[r + 1];
    }
    ((LAS float*)(lds + L_SEG))[seg * 128 + d] = (dir == 0) ? arr[15] : arr[0];
    __syncthreads();
    float tot, off;
    {
        const LAS float* sg = (const LAS float*)(lds + L_SEG);
        const float s0 = sg[d], s1 = sg[128 + d], s2 = sg[256 + d], s3 = sg[384 + d];
        tot = (s0 + s1) + (s2 + s3);
        if (dir == 0) off = (seg > 0 ? s0 : 0.f) + (seg > 1 ? s1 : 0.f) + (seg > 2 ? s2 : 0.f);
        else          off = (seg < 1 ? s1 : 0.f) + (seg < 2 ? s2 : 0.f) + (seg < 3 ? s3 : 0.f);
        if (seg == 0) { ((LAS float*)(lds + L_DEC))[d] = __expf(tot); ltot += tot; }
    }
    {
        unsigned kep[8];
        const bf16_t* kp = Kb + (size_t)(row0 + seg * 16) * KW + h * HK + d;
        const bf16_t* qp = Qb + (size_t)(row0 + seg * 16) * KW + h * HK + d;
        LAS unsigned char* qd = lds + L_QD + (seg * 16) * P_QD + d * 2;
#pragma unroll
        for (int r2 = 0; r2 < 8; ++r2) {
            float ke2[2];
#pragma unroll
            for (int e = 0; e < 2; ++e) { const int r = 2 * r2 + e; const float cum = arr[r] + off; const float kf = bf1(kp[(size_t)r * KW]);
                ke2[e] = kf * __expf(tot - cum);
                if (NEED_O) { const float qf = bf1(qp[(size_t)r * KW]);
                    *(LAS bf16_t*)(qd + r * P_QD) = (bf16_t)(cvt_pk_bf16(qf * __expf(cum), 0.f) & 0xffffu);
                    *(LAS bf16_t*)(qd + (L_KI - L_QD) + r * P_QD) = (bf16_t)(cvt_pk_bf16(kf * __expf(-cum), 0.f) & 0xffffu); } }
            kep[r2] = cvt_pk_bf16(ke2[0], ke2[1]);
        }
        LAS unsigned char* kt = lds + L_KET + d * P_T + seg * 32;
        *(LAS u32x4*)(kt) = (u32x4){kep[0], kep[1], kep[2], kep[3]}; *(LAS u32x4*)(kt + 16) = (u32x4){kep[4], kep[5], kep[6], kep[7]};
    }
    __syncthreads();
    asm volatile("" : "+v"(tid));
    const int fr = tid & 15, fq = (tid & 63) >> 4;
    if (NEED_O) {
        {
            const int it = w >> 1, jt0 = (w & 1) * 2;
            f32x4 p[2] = {(f32x4){0.f, 0.f, 0.f, 0.f}, (f32x4){0.f, 0.f, 0.f, 0.f}};
            const LAS unsigned char* qb_ = lds + L_QD + fr * P_QD + fq * 16 + it * 16 * P_QD;
            const LAS unsigned char* kb_ = lds + L_KI + fr * P_QD + fq * 16 + jt0 * 16 * P_QD;
#pragma unroll
            for (int ks = 0; ks < 4; ++ks) {
                const bf16x8 qf = *(const LAS bf16x8*)(qb_ + ks * 64);
#pragma unroll
                for (int t = 0; t < 2; ++t) { const bf16x8 kf = *(const LAS bf16x8*)(kb_ + t * 16 * P_QD + ks * 64);
                    p[t] = __builtin_amdgcn_mfma_f32_16x16x32_bf16(kf, qf, p[t], 0, 0, 0); } }
            LAS unsigned char* sw = lds + L_SC + (it * 16 + fr) * P_T + (jt0 * 16 + fq * 4) * 2;
#pragma unroll
            for (int t = 0; t < 2; ++t) { const int i = it * 16 + fr, jb = (jt0 + t) * 16 + fq * 4; float v[4];
#pragma unroll
                for (int jj = 0; jj < 4; ++jj) { const int j = jb + jj; const bool keep = (dir == 0) ? (j <= i) : (j > i); v[jj] = keep ? p[t][jj] : 0.f; }
                *(LAS u32x2*)(sw + t * 32) = (u32x2){cvt_pk_bf16(v[0], v[1]), cvt_pk_bf16(v[2], v[3])}; }
        }
        __syncthreads();
        f32x4 o[4][2];
#pragma unroll
        for (int a = 0; a < 4; ++a) { o[a][0] = (f32x4){0.f, 0.f, 0.f, 0.f}; o[a][1] = (f32x4){0.f, 0.f, 0.f, 0.f}; }
        {
            const LAS unsigned char* vb_ = lds + L_VT + ((2 * w) * 16 + fr) * P_T + fq * 16;
            const LAS unsigned char* sb_ = lds + L_SC + fr * P_T + fq * 16;
#pragma unroll
            for (int ks = 0; ks < 2; ++ks) { bf16x8 vf[2];
#pragma unroll
                for (int bb = 0; bb < 2; ++bb) vf[bb] = *(const LAS bf16x8*)(vb_ + bb * 16 * P_T + ks * 64);
#pragma unroll
                for (int a = 0; a < 4; ++a) { const bf16x8 sf = *(const LAS bf16x8*)(sb_ + a * 16 * P_T + ks * 64);
#pragma unroll
                    for (int bb = 0; bb < 2; ++bb) o[a][bb] = __builtin_amdgcn_mfma_f32_16x16x32_bf16(sf, vf[bb], o[a][bb], 0, 0, 0); } }
            const LAS unsigned char* qa_ = lds + L_QD + fr * P_QD + fq * 8;
#pragma unroll
            for (int p = 0; p < 4; ++p) { bf16x8 sb[2];
#pragma unroll
                for (int bb = 0; bb < 2; ++bb) { const f32x4 s0 = St[2 * p][bb], s1 = St[2 * p + 1][bb];
                    const u32x4 pk = (u32x4){cvt_pk_bf16(s0[0], s0[1]), cvt_pk_bf16(s0[2], s0[3]), cvt_pk_bf16(s1[0], s1[1]), cvt_pk_bf16(s1[2], s1[3])};
                    sb[bb] = __builtin_bit_cast(bf16x8, pk); }
#pragma unroll
                for (int a = 0; a < 4; ++a) {
                    const u32x2 lo = *(const LAS u32x2*)(qa_ + a * 16 * P_QD + p * 64), hi = *(const LAS u32x2*)(qa_ + a * 16 * P_QD + p * 64 + 32);
                    const bf16x8 qa = __builtin_bit_cast(bf16x8, (u32x4){lo.x, lo.y, hi.x, hi.y});
#pragma unroll
                    for (int bb = 0; bb < 2; ++bb) o[a][bb] = __builtin_amdgcn_mfma_f32_16x16x32_bf16(qa, sb[bb], o[a][bb], 0, 0, 0); }
                __builtin_amdgcn_sched_barrier(0); }
        }
        {
        float* ofp = OF + (size_t)row0 * D + h * HV; bf16_t* sgp = SGG + (size_t)row0 * D + h * HV;
        const unsigned vo = (unsigned)((fq * 4) * D + (2 * w) * 16 + fr);
        if (dir == 0) {
#pragma unroll
            for (int a = 0; a < 4; ++a) {
#pragma unroll
                for (int bb = 0; bb < 2; ++bb)
#pragma unroll
                    for (int jj = 0; jj < 4; ++jj) ofp[vo + (unsigned)((a * 16 + jj) * D + bb * 16)] = o[a][bb][jj];
                __builtin_amdgcn_sched_barrier(0); }
        } else {
            float ss[4][4];
#pragma unroll
            for (int a = 0; a < 4; ++a) {
#pragma unroll
                for (int jj = 0; jj < 4; ++jj) { float s = 0.f;
#pragma unroll
                    for (int bb = 0; bb < 2; ++bb) { o[a][bb][jj] += ofp[vo + (unsigned)((a * 16 + jj) * D + bb * 16)]; s += o[a][bb][jj] * o[a][bb][jj]; }
                    s += __shfl_xor(s, 1); s += __shfl_xor(s, 2); s += __shfl_xor(s, 4); s += __shfl_xor(s, 8); ss[a][jj] = s; }
                __builtin_amdgcn_sched_barrier(0); }
            if (fr == 0) {
#pragma unroll
                for (int a = 0; a < 4; ++a) *(LAS f32x4*)(lds + L_RS + (w * 64 + a * 16 + fq * 4) * 4) = (f32x4){ss[a][0], ss[a][1], ss[a][2], ss[a][3]};
            }
            __syncthreads();
            float gn[2];
#pragma unroll
            for (int bb = 0; bb < 2; ++bb) gn[bb] = gnorm[(2 * w + bb) * 16 + fr];
#pragma unroll
            for (int a = 0; a < 4; ++a) { f32x4 t4 = (f32x4){0.f, 0.f, 0.f, 0.f};
#pragma unroll
                for (int ww = 0; ww < 8; ++ww) t4 += *(const LAS f32x4*)(lds + L_RS + (ww * 64 + a * 16 + fq * 4) * 4);
#pragma unroll
                for (int jj = 0; jj < 4; ++jj) { const float rstd = __builtin_amdgcn_rsqf(t4[jj] * (1.f / HV) + RMS_EPS);
#pragma unroll
                    for (int bb = 0; bb < 2; ++bb) { const unsigned idx = vo + (unsigned)((a * 16 + jj) * D + bb * 16);
                        const float gate = bf1(sgp[idx]);
                        sgp[idx] = (bf16_t)(cvt_pk_bf16(o[a][bb][jj] * rstd * gn[bb] * gate, 0.f) & 0xffffu); } }
                __builtin_amdgcn_sched_barrier(0); }
        }
        }
    }
    {
        const LAS unsigned char* dp = lds + L_DEC + fq * 16;
#pragma unroll
        for (int a = 0; a < 8; ++a) { const f32x4 dc = *(const LAS f32x4*)(dp + a * 64); St[a][0] *= dc; St[a][1] *= dc; }
        const LAS unsigned char* vb_ = lds + L_VT + ((2 * w) * 16 + fr) * P_T + fq * 16;
        const LAS unsigned char* kb_ = lds + L_KET + fr * P_T + fq * 16;
#pragma unroll
        for (int ks = 0; ks < 2; ++ks) { bf16x8 vf[2];
#pragma unroll
            for (int bb = 0; bb < 2; ++bb) vf[bb] = *(const LAS bf16x8*)(vb_ + bb * 16 * P_T + ks * 64);
#pragma unroll
            for (int a = 0; a < 8; ++a) { const bf16x8 kf = *(const LAS bf16x8*)(kb_ + a * 16 * P_T + ks * 64);
#pragma unroll
                for (int bb = 0; bb < 2; ++bb) St[a][bb] = __builtin_amdgcn_mfma_f32_16x16x32_bf16(kf, vf[bb], St[a][bb], 0, 0, 0); } }
    }
}

#define XB_TMO      128
#define XB_XCNT(j)  (256  + 64 * (j))
#define XB_XSUB(j)  (1280 + 64 * (j))
#define XB_XGEN(j)  (2304 + 64 * (j))
#define XB_TOP      3328
#define XB_TOPGEN   3392
#define XCD_BAR_WORDS 3456
#define XB_SPIN_CAP (1u << 18)
__device__ __forceinline__ unsigned xb_ld(unsigned* p)              { return __hip_atomic_load(p, __ATOMIC_RELAXED, __HIP_MEMORY_SCOPE_AGENT); }
__device__ __forceinline__ unsigned xb_add(unsigned* p, unsigned v) { return __hip_atomic_fetch_add(p, v, __ATOMIC_RELAXED, __HIP_MEMORY_SCOPE_AGENT); }
__device__ __forceinline__ unsigned xb_xcc_id() { return (unsigned)__builtin_amdgcn_s_getreg((3 << 11) | 20) & 0xFu; }
#define XB_SPIN(cond, bar) do { unsigned _sp = 0; while (cond) { __builtin_amdgcn_s_sleep(1); \
    if ((++_sp & 255u) == 0u) { if (xb_ld(&(bar)[XB_TMO])) break; if (_sp > XB_SPIN_CAP) { atomicAdd(&(bar)[XB_TMO], 1u); break; } } } } while (0)
__device__ __forceinline__ void xcd_barrier_complete(unsigned* bar, unsigned x, unsigned& nloc, unsigned& nx) {
    const unsigned G = gridDim.x;
    unsigned sum, cnt, mine, sp = 0u;
    for (;;) {
        sum = 0u; cnt = 0u; mine = 0u;
#pragma unroll
        for (unsigned j = 0; j < 16; ++j) { const unsigned c = xb_ld(&bar[XB_XCNT(j)]); sum += c; cnt += (c > 0u) ? 1u : 0u; mine = (j == x) ? c : mine; }
        if (sum == G) break;
        __builtin_amdgcn_s_sleep(1);
        if ((++sp & 255u) == 0u) { if (xb_ld(&bar[XB_TMO])) break; if (sp > XB_SPIN_CAP) { atomicAdd(&bar[XB_TMO], 1u); break; } }
    }
    nloc = mine > 0u ? mine : 1u; nx = cnt > 0u ? cnt : 1u;
}
__device__ __forceinline__ void xcd_barrier(unsigned* bar, volatile LAS unsigned* st) {
    asm volatile("s_waitcnt vmcnt(0)" ::: "memory");
    __syncthreads();
    if (threadIdx.x == 0) {
        const unsigned x = xb_xcc_id();
        __builtin_amdgcn_s_waitcnt(0);
        unsigned nloc = st[0], nx = st[1];
        if (nloc == 0u) { xcd_barrier_complete(bar, x, nloc, nx); st[0] = nloc; st[1] = nx; }
        const unsigned old = xb_add(&bar[XB_XSUB(x)], 1u);
        const unsigned gen = old / nloc;
        if (old + 1u == (gen + 1u) * nloc) {
            __builtin_amdgcn_fence(__ATOMIC_RELEASE, "agent");
            asm volatile("s_waitcnt vmcnt(0)" ::: "memory");
            const unsigned og = xb_add(&bar[XB_TOP], 1u);
            const unsigned tg = og / nx;
            if (og + 1u == (tg + 1u) * nx) xb_add(&bar[XB_TOPGEN], 1u);
            else XB_SPIN(xb_ld(&bar[XB_TOPGEN]) == tg, bar);
            __builtin_amdgcn_fence(__ATOMIC_ACQUIRE, "agent");
            xb_add(&bar[XB_XGEN(x)], 1u);
            asm volatile("s_waitcnt vmcnt(0)" ::: "memory");
        } else {
            XB_SPIN(xb_ld(&bar[XB_XGEN(x)]) == gen, bar);
            __builtin_amdgcn_fence(__ATOMIC_ACQUIRE, "agent");
            asm volatile("s_waitcnt vmcnt(0)" ::: "memory");
        }
    }
    __syncthreads();
}

struct Args { const float* in[17]; float* out; unsigned char* ws; int ph_lo, ph_hi; };

__global__ void __launch_bounds__(NTHREADS, 2) fwd_kernel(Args args) {
    extern __shared__ __attribute__((aligned(16))) unsigned char lds_raw[];
    LAS unsigned char* lds = (LAS unsigned char*)lds_raw;
    cg::grid_group grid = cg::this_grid();
    const int tid = threadIdx.x, lane = tid & 63, wave = __builtin_amdgcn_readfirstlane(tid >> 6);
    const int G = gridDim.x, bid = blockIdx.x;
    const int gw = bid * NWAVES + wave, NGW = G * NWAVES;
    typedef const __attribute__((address_space(4))) unsigned char* kptr_t;
#define KP_DECL kptr_t kp = (kptr_t)__builtin_amdgcn_kernarg_segment_ptr(); asm volatile("" : "+s"(kp)); unsigned char* ws = *(unsigned char* const __attribute__((address_space(4)))*)(kp + 144); (void)ws
#define KIN(i) (*(const float* const __attribute__((address_space(4)))*)(kp + 8 * (i)))
#define KOUT (*(float* const __attribute__((address_space(4)))*)(kp + 136))
    int lo, hi; { kptr_t kp0 = (kptr_t)__builtin_amdgcn_kernarg_segment_ptr(); lo = *(const int __attribute__((address_space(4)))*)(kp0 + 152); hi = *(const int __attribute__((address_space(4)))*)(kp0 + 156); }
#ifndef PHMASK
#define PHMASK 0x7ff
#endif
#define IN(k) (((PHMASK >> (k)) & 1) && lo <= (k) && (k) < hi)
    volatile LAS unsigned* bst = (volatile LAS unsigned*)(lds + LDS_BYTES - 64);
    if (threadIdx.x == 0) { bst[0] = 0u; bst[1] = 0u;
        if (hi - lo > 1) { unsigned* bar0 = (unsigned*)(*(unsigned char* const __attribute__((address_space(4)))*)((kptr_t)__builtin_amdgcn_kernarg_segment_ptr() + 144) + WS_BAR); (void)xb_add(&bar0[XB_XCNT(xb_xcc_id())], 1u); } }
    __syncthreads();
#define SEAM(k) do { if (IN(k) && IN((k) + 1)) { if ((k) == 0) grid.sync(); else { \
        unsigned* bar_ = (unsigned*)(*(unsigned char* const __attribute__((address_space(4)))*)((kptr_t)__builtin_amdgcn_kernarg_segment_ptr() + 144) + WS_BAR); \
        xcd_barrier(bar_, bst); } } } while (0)

    if (IN(0)) {
        KP_DECL; const float* cvec = KIN(1); const float* w_ada = KIN(2); const float* w_in = KIN(6); const float* pool_w = KIN(7); const float* w_pp = KIN(14); const float* w_pg = KIN(15); const float* w_out = KIN(16);
        float* adaacc = (float*)(ws + WS_ADA); bf16_t* WIN = (bf16_t*)(ws + WS_WIN); bf16_t* WPP = (bf16_t*)(ws + WS_WPP); bf16_t* WPG = (bf16_t*)(ws + WS_WPG); bf16_t* WOUT = (bf16_t*)(ws + WS_WOUT); bf16_t* POOLW = (bf16_t*)(ws + WS_POOLW);
        for (int it = gw; it < 48 * 16; it += NGW) { const int nc = it % 48, ksl = it / 48; const int n = nc * 64 + lane; float s = 0.f;
#pragma unroll 8
            for (int kk = 0; kk < 64; ++kk) { const int k = ksl * 64 + kk; const float cv = cvec[k]; s += cv * sigmoidf_(cv) * w_ada[(size_t)k * (3 * D) + n]; }
            atomicAdd(adaacc + n, s); }
        LAS float* scr = (LAS float*)(lds + wave * 16384);
        constexpr int I_IN = 16 * 225, I_SQ = 16 * 32, I_PW = 4 * 8;
        constexpr int NIT = I_IN + 3 * I_SQ + 4 * I_PW;
        for (int it = gw; it < NIT; it += NGW) { int r = it;
            if (r < I_IN) { const int kb = r / 225, nb = r % 225; const int drow = nb < 160 ? nb * 32 : (nb == 160 ? NPROJ : (nb - 1) * 32);
                transpose_item(w_in, D, 7200, WIN, kb * 64, nb * 32, drow - 0, scr, lane); continue; } r -= I_IN;
            if (r < 3 * I_SQ) { const int which = r / I_SQ, rr = r % I_SQ; const int kb = rr / 32, nb = rr % 32;
                const float* W = which == 0 ? w_pp : (which == 1 ? w_pg : w_out); bf16_t* WT = which == 0 ? WPP : (which == 1 ? WPG : WOUT);
                transpose_item(W, D, D, WT, kb * 64, nb * 32, nb * 32, scr, lane); continue; } r -= 3 * I_SQ;
            { const int gI = r / I_PW, rr = r % I_PW; const int kb = rr / 8, nb = rr % 8;
              transpose_item(pool_w + (size_t)gI * 65536, 256, 256, POOLW, kb * 64, nb * 32, gI * 256 + nb * 32, scr, lane); }
        }
    }
    SEAM(0);

    if (IN(1)) {
        KP_DECL; const float* x = KIN(0); const float* b_ada = KIN(3); const float* g_pre = KIN(4); const float* adaacc = (const float*)(ws + WS_ADA); const bf16_t* WIN = (const bf16_t*)(ws + WS_WIN); float* LR = (float*)(ws + WS_LR); bf16_t* H = (bf16_t*)KOUT;
        constexpr int HS_PITCH = 2064;
        constexpr int L_HS = 0, L_RED = 16 * HS_PITCH;
        f32x4 gs[4], sh[4];
#pragma unroll
        for (int j = 0; j < 4; ++j) { const int c0 = 4 * lane + 256 * j;
            const f32x4 shv = *(const f32x4*)(adaacc + c0) + *(const f32x4*)(b_ada + c0);
            const f32x4 scv = *(const f32x4*)(adaacc + D + c0) + *(const f32x4*)(b_ada + D + c0);
            gs[j] = *(const f32x4*)(g_pre + c0) * (scv + 1.f); sh[j] = shv; }
        const int fr = lane & 15, fq = lane >> 4;
        bf16x8 bfr[2][4];
#pragma unroll
        for (int nt = 0; nt < 2; ++nt)
#pragma unroll
            for (int kk = 0; kk < 4; ++kk) bfr[nt][kk] = *(const bf16x8*)(WIN + (size_t)(NPROJ + nt * 16 + fr) * D + (4 * wave + kk) * 32 + fq * 8);
        for (int grp = bid; grp < S / 16; grp += G) {
#pragma unroll
            for (int rr = 0; rr < 2; ++rr) { const int rl = 2 * wave + rr; const size_t row = (size_t)grp * 16 + rl;
                const f32x4* xr = (const f32x4*)(x + row * D) + lane; f32x4 v[4]; float s = 0.f;
#pragma unroll
                for (int j = 0; j < 4; ++j) { v[j] = xr[64 * j]; s += (v[j][0] * v[j][0] + v[j][1] * v[j][1]) + (v[j][2] * v[j][2] + v[j][3] * v[j][3]); }
                const float rstd = __builtin_amdgcn_rsqf(wave_sum(s) * (1.f / D) + RMS_EPS);
#pragma unroll
                for (int j = 0; j < 4; ++j) { const f32x4 hv = v[j] * rstd * gs[j] + sh[j]; const u32x2 pk = (u32x2){cvt_pk_bf16(hv[0], hv[1]), cvt_pk_bf16(hv[2], hv[3])};
                    *(u32x2*)(H + row * D + 4 * lane + 256 * j) = pk; *(LAS u32x2*)(lds + L_HS + rl * HS_PITCH + (4 * lane + 256 * j) * 2) = pk; } }
            __syncthreads();
            f32x4 pa[2] = {(f32x4){0.f, 0.f, 0.f, 0.f}, (f32x4){0.f, 0.f, 0.f, 0.f}};
#pragma unroll
            for (int kk = 0; kk < 4; ++kk) { const bf16x8 af = *(const LAS bf16x8*)(lds + L_HS + fr * HS_PITCH + ((4 * wave + kk) * 32 + fq * 8) * 2);
                pa[0] = __builtin_amdgcn_mfma_f32_16x16x32_bf16(af, bfr[0][kk], pa[0], 0, 0, 0); pa[1] = __builtin_amdgcn_mfma_f32_16x16x32_bf16(af, bfr[1][kk], pa[1], 0, 0, 0); }
            *(LAS f32x4*)(lds + L_RED + ((wave * 2 + 0) * 64 + lane) * 16) = pa[0]; *(LAS f32x4*)(lds + L_RED + ((wave * 2 + 1) * 64 + lane) * 16) = pa[1];
            __syncthreads();
            { const int nt = tid >> 8, ll = (tid >> 2) & 63, jj = tid & 3; float s = 0.f;
#pragma unroll
              for (int ww = 0; ww < 8; ++ww) s += *(const LAS float*)(lds + L_RED + ((ww * 2 + nt) * 64 + ll) * 16 + jj * 4);
              LR[((size_t)grp * 16 + (ll >> 4) * 4 + jj) * 32 + nt * 16 + (ll & 15)] = s; }
        }
        __syncthreads();
    }
    SEAM(1);

    if (IN(2)) {
        KP_DECL; const bf16_t* H = (const bf16_t*)KOUT; const bf16_t* WIN = (const bf16_t*)(ws + WS_WIN);
        pg8::Gemm g{H, WIN, S, NPROJ, D, D, 0}; pg8::StaticOrder so; so.init(S, NPROJ, G, bid);
        pg8::EpiProj E{ws};
        pg8::gemm_phase<pg8::EpiProj>(lds, g, so, E);
    }
    SEAM(2);

    if (IN(3)) {
        KP_DECL; const bf16_t* PIN = (const bf16_t*)(ws + WS_PIN); bf16_t* POOLED = (bf16_t*)KOUT;
        for (int it = bid * NTHREADS + tid; it < (S / 16) * 128; it += G * NTHREADS) { const int cc = it & 127, rb = it >> 7; const int r0 = rb * 16, c0 = cc * 8; const int hw = 1 << (c0 >> 8);
            float sum[8];
#pragma unroll
            for (int e = 0; e < 8; ++e) sum[e] = 0.f;
            for (int r = r0 - hw; r < r0 + hw; ++r) if (r >= 0 && r < S) { f32x4 a, b; pg8::unpack8(*(const u32x4*)(PIN + (size_t)r * D + c0), a, b);
#pragma unroll
                for (int e = 0; e < 4; ++e) { sum[e] += a[e]; sum[4 + e] += b[e]; } }
            for (int s = r0; s < r0 + 16; ++s) { const int lo_ = max(s - hw, 0), hi_ = min(s + hw, S); const float inv = 1.f / (float)(hi_ - lo_);
                f32x4 a, b; pg8::unpack8(*(const u32x4*)(PIN + (size_t)s * D + c0), a, b); f32x4 o0, o1;
#pragma unroll
                for (int e = 0; e < 4; ++e) { o0[e] = sum[e] * inv - a[e]; o1[e] = sum[4 + e] * inv - b[e]; }
                *(u32x4*)(POOLED + (size_t)s * D + c0) = pg8::pack8(o0, o1);
                if (s + hw < S) { pg8::unpack8(*(const u32x4*)(PIN + (size_t)(s + hw) * D + c0), a, b);
#pragma unroll
                    for (int e = 0; e < 4; ++e) { sum[e] += a[e]; sum[4 + e] += b[e]; } }
                if (s - hw >= 0) { pg8::unpack8(*(const u32x4*)(PIN + (size_t)(s - hw) * D + c0), a, b);
#pragma unroll
                    for (int e = 0; e < 4; ++e) { sum[e] -= a[e]; sum[4 + e] -= b[e]; } } }
        }
    }
    SEAM(3);

    if (IN(4)) {
        KP_DECL; const float* pool_scale = KIN(8); const bf16_t* POOLED = (const bf16_t*)KOUT; bf16_t* A2 = (bf16_t*)((unsigned char*)KOUT + 32 * MiB); const bf16_t* POOLW = (const bf16_t*)(ws + WS_POOLW); const bf16_t* SPG = (const bf16_t*)(ws + WS_SPG);
        pg8::Gemm g{POOLED, POOLW, S, D, 256, D, 256}; pg8::StaticOrder so; so.init(S, D, G, bid);
        pg8::EpiPool E{SPG, A2, pool_scale};
        pg8::gemm_phase<pg8::EpiPool>(lds, g, so, E);
    }
    SEAM(4);

    if (IN(5)) {
        KP_DECL; const float* gk_up_f = KIN(9); const float* gk_bias_f = KIN(10); const float* gk_up_b = KIN(11); const float* gk_bias_b = KIN(12);
        const bf16_t* A2 = (const bf16_t*)((unsigned char*)KOUT + 32 * MiB); const bf16_t* WPP = (const bf16_t*)(ws + WS_WPP); bf16_t* SBP = (bf16_t*)(ws + WS_SBP);
        const bf16_t* Qb = (const bf16_t*)(ws + WS_Q); const bf16_t* Kb = (const bf16_t*)(ws + WS_K); const bf16_t* Vb = (const bf16_t*)(ws + WS_V); const float* LR = (const float*)(ws + WS_LR); float* LTOT = (float*)(ws + WS_LTOT); float* STATES = (float*)(ws + WS_STATES);
        { pg8::Gemm g{A2, WPP, S, D, D, D, 0}; pg8::StaticOrder so; so.init(S, D, G, bid);
          pg8::EpiYPool E{SBP};
          pg8::gemm_phase<pg8::EpiYPool>(lds, g, so, E); }
        for (int item = bid; item < NSC * NH * 2; item += G) { const int dir = item & 1, h = (item >> 1) & 3, sc = item >> 3;
            int tl = tid; asm volatile("" : "+v"(tl));
            const int d = tl & 127; const float* upp = dir ? gk_up_b : gk_up_f; const float* bp = dir ? gk_bias_b : gk_bias_f;
            __syncthreads();
#pragma unroll
            for (int m = 0; m < 4; ++m) ((LAS float*)(lds + L_UP))[(m * 4 + (tl >> 7)) * 128 + d] = upp[(m * 4 + (tl >> 7)) * KW + h * HK + d];
            const float bias = bp[h * HK + d];
            f32x4 St[8][2];
#pragma unroll
            for (int a = 0; a < 8; ++a) { St[a][0] = (f32x4){0.f, 0.f, 0.f, 0.f}; St[a][1] = (f32x4){0.f, 0.f, 0.f, 0.f}; }
            float ltot = 0.f;
            for (int cc = 0; cc < SCN; ++cc) { const int c = dir ? (SCN - 1 - cc) : cc; const int row0 = (sc * SCN + c) * CH;
                gla_chunk<false>(lds, tl, row0, h, dir, Qb, Kb, Vb, LR, bias, St, ltot, nullptr, nullptr, nullptr); }
            float* sp = STATES + ((size_t)(dir * NSC + sc) * NH + h) * (HK * HV);
            const int fr = tl & 15, fq = (tl & 63) >> 4; const unsigned so = (unsigned)((fq * 4) * HV + (2 * wave) * 16 + fr);
#pragma unroll
            for (int a = 0; a < 8; ++a) { unsigned soa = so + (unsigned)(a * 16 * HV); asm volatile("" : "+v"(soa));
#pragma unroll
                for (int bb = 0; bb < 2; ++bb)
#pragma unroll
                    for (int jj = 0; jj < 4; ++jj) sp[soa + (unsigned)(jj * HV + bb * 16)] = St[a][bb][jj];
                __builtin_amdgcn_sched_barrier(0); }
            if (tl < 128) LTOT[((size_t)(dir * NSC + sc) * NH + h) * HK + tl] = ltot;
        }
    }
    SEAM(5);

    if (IN(6)) {
        KP_DECL; const float* LTOT = (const float*)(ws + WS_LTOT); float* STATES = (float*)(ws + WS_STATES);
        for (int e = bid * NTHREADS + tid; e < 2 * NH * HK * HV; e += G * NTHREADS) { const int dir = e / (NH * HK * HV), rem = e % (NH * HK * HV), h = rem / (HK * HV), idx = rem % (HK * HV), dk = idx / HV;
            float carry = 0.f;
            for (int i = 0; i < NSC; ++i) { const int sc = dir ? (NSC - 1 - i) : i; const size_t o = ((size_t)(dir * NSC + sc) * NH + h);
                float* p = STATES + o * (HK * HV) + idx; const float t = *p; *p = carry; carry = __expf(LTOT[o * HK + dk]) * carry + t; }
        }
    }
    SEAM(6);

    if (IN(7)) {
        KP_DECL; const float* gk_up_f = KIN(9); const float* gk_bias_f = KIN(10); const float* gk_up_b = KIN(11); const float* gk_bias_b = KIN(12); const float* gla_norm_g = KIN(13);
        const bf16_t* Qb = (const bf16_t*)(ws + WS_Q); const bf16_t* Kb = (const bf16_t*)(ws + WS_K); const bf16_t* Vb = (const bf16_t*)(ws + WS_V); const float* LR = (const float*)(ws + WS_LR); const float* STATES = (const float*)(ws + WS_STATES);
        bf16_t* SGG = (bf16_t*)(ws + WS_SGG); float* OF = KOUT;
        for (int item = bid; item < NSC * NH; item += G) { const int h = item & 3, sc = item >> 2;
            int tl = tid; asm volatile("" : "+v"(tl));
            const int d = tl & 127, fr = tl & 15, fq = (tl & 63) >> 4;
            for (int dir = 0; dir < 2; ++dir) {
                const float* upp = dir ? gk_up_b : gk_up_f; const float* bp = dir ? gk_bias_b : gk_bias_f;
                __syncthreads();
#pragma unroll
                for (int m = 0; m < 4; ++m) ((LAS float*)(lds + L_UP))[(m * 4 + (tl >> 7)) * 128 + d] = upp[(m * 4 + (tl >> 7)) * KW + h * HK + d];
                const float bias = bp[h * HK + d];
                const float* sp = STATES + ((size_t)(dir * NSC + sc) * NH + h) * (HK * HV);
                const unsigned so = (unsigned)((fq * 4) * HV + (2 * wave) * 16 + fr);
                f32x4 St[8][2];
#pragma unroll
                for (int a = 0; a < 8; ++a) { unsigned soa = so + (unsigned)(a * 16 * HV); asm volatile("" : "+v"(soa));
#pragma unroll
                    for (int bb = 0; bb < 2; ++bb)
#pragma unroll
                        for (int jj = 0; jj < 4; ++jj) St[a][bb][jj] = sp[soa + (unsigned)(jj * HV + bb * 16)];
                    __builtin_amdgcn_sched_barrier(0); }
                float ltot = 0.f;
                for (int cc = 0; cc < SCN; ++cc) { const int c = dir ? (SCN - 1 - cc) : cc; const int row0 = (sc * SCN + c) * CH;
                    gla_chunk<true>(lds, tl, row0, h, dir, Qb, Kb, Vb, LR, bias, St, ltot, OF, SGG, gla_norm_g); }
            }
        }
    }
    SEAM(7);

    if (IN(8)) {
        KP_DECL; const bf16_t* SGG = (const bf16_t*)(ws + WS_SGG); const bf16_t* WPG = (const bf16_t*)(ws + WS_WPG); const bf16_t* SBP = (const bf16_t*)(ws + WS_SBP); bf16_t* SBG = (bf16_t*)(ws + WS_SBG);
        pg8::Gemm g{SGG, WPG, S, D, D, D, 0}; pg8::StaticOrder so; so.init(S, D, G, bid);
        pg8::EpiYGla E{SBP, SBG};
        pg8::gemm_phase<pg8::EpiYGla>(lds, g, so, E);
    }
    SEAM(8);

    if (IN(9)) {
        KP_DECL; const bf16_t* SBG = (const bf16_t*)(ws + WS_SBG); const bf16_t* WOUT = (const bf16_t*)(ws + WS_WOUT); float* OUT = KOUT; float* rowsq = (float*)(ws + WS_ROWSQ);
        pg8::Gemm g{SBG, WOUT, S, D, D, D, 0}; pg8::StaticOrder so; so.init(S, D, G, bid);
        pg8::EpiOut E{OUT, rowsq};
        pg8::gemm_phase<pg8::EpiOut>(lds, g, so, E);
    }
    SEAM(9);

    if (IN(10)) {
        KP_DECL; const float* x = KIN(0); const float* b_ada = KIN(3); const float* g_post = KIN(5); const float* adaacc = (const float*)(ws + WS_ADA); const float* rowsq = (const float*)(ws + WS_ROWSQ); float* OUT = KOUT;
        for (size_t i4 = (size_t)bid * NTHREADS + tid; i4 < (size_t)S * D / 4; i4 += (size_t)G * NTHREADS) { const int row = (int)(i4 >> 8), c0 = (int)(i4 & 255) * 4;
            const float rstd = __builtin_amdgcn_rsqf(rowsq[row] * (1.f / D) + RMS_EPS);
            const f32x4 gate = *(const f32x4*)(adaacc + 2 * D + c0) + *(const f32x4*)(b_ada + 2 * D + c0);
            const f32x4 gp = *(const f32x4*)(g_post + c0); const f32x4 ov = *(const f32x4*)(OUT + i4 * 4); const f32x4 xv = *(const f32x4*)(x + i4 * 4);
            *(f32x4*)(OUT + i4 * 4) = xv + gate * (ov * rstd * gp); }
    }
#undef IN
#undef SEAM
}

constexpr int NPHASES = 11;
extern "C" void kernel_launch(void* const* d_in, const int* in_sizes, int n_in, void* d_out, int out_size, void* d_ws, size_t ws_size, hipStream_t stream) {
    static int grid = 0;
    if (grid == 0) {
        if (n_in != 17 || out_size != S * D || ws_size < WS_END) { fprintf(stderr, "kernel_launch: unexpected problem shape (n_in %d out %d ws %zu)\n", n_in, out_size, ws_size); grid = -1; return; }
        int dev = 0, cus = 0, per_cu = 0;
        hipGetDevice(&dev); hipDeviceGetAttribute(&cus, hipDeviceAttributeMultiprocessorCount, dev);
        if (hipFuncSetAttribute((const void*)fwd_kernel, hipFuncAttributeMaxDynamicSharedMemorySize, LDS_BYTES) != hipSuccess) { fprintf(stderr, "kernel_launch: hipFuncSetAttribute failed\n"); grid = -1; return; }
        if (hipOccupancyMaxActiveBlocksPerMultiprocessor(&per_cu, (const void*)fwd_kernel, NTHREADS, LDS_BYTES) != hipSuccess || per_cu < 1) { fprintf(stderr, "kernel_launch: occupancy query says %d\n", per_cu); per_cu = 1; (void)hipGetLastError(); }
        grid = cus * 1;
        if (grid > cus * per_cu) grid = cus * per_cu;
    }
    if (grid < 0) return;
    hipMemsetAsync((char*)d_ws + WS_CTL, 0, CTL_ZERO_BYTES, stream);
    Args a{};
    for (int i = 0; i < 17; ++i) a.in[i] = (const float*)d_in[i];
    a.out = (float*)d_out; a.ws = (unsigned char*)d_ws;
#if ONE_LAUNCH
    a.ph_lo = 0; a.ph_hi = NPHASES;
    void* kargs[] = {&a};
    hipError_t e = hipLaunchCooperativeKernel((const void*)fwd_kernel, dim3(grid), dim3(NTHREADS), kargs, LDS_BYTES, stream);
    if (e != hipSuccess) fprintf(stderr, "cooperative launch failed: %s (grid %d)\n", hipGetErrorString(e), grid);
#else
    for (int p = 0; p < NPHASES; ++p) { a.ph_lo = p; a.ph_hi = p + 1;
        hipLaunchKernelGGL(fwd_kernel, dim3(grid), dim3(NTHREADS), LDS_BYTES, stream, a); }
#endif
}
```

```cpp
#include <hip/hip_runtime.h>
#include <hip/hip_cooperative_groups.h>
#include <cstdio>
#include <cstdint>
namespace cg = cooperative_groups;

#ifndef ONE_LAUNCH
#define ONE_LAUNCH 1
#endif

#define LAS __attribute__((address_space(3)))
typedef unsigned short bf16_t;
typedef short bf16x8 __attribute__((ext_vector_type(8)));
typedef float f32x4 __attribute__((ext_vector_type(4)));
typedef unsigned u32x4 __attribute__((ext_vector_type(4)));
typedef unsigned u32x2 __attribute__((ext_vector_type(2)));

constexpr int S = 16384, D = 1024, NPROJ = 7168, KW = 512, HK = 128, HV = 256, NH = 4, RANK = 16;
constexpr int CH = 64, SCN = 4, NSC = S / (CH * SCN);
constexpr float RMS_EPS = 1e-6f;
constexpr int NTHREADS = 512, NWAVES = 8;
constexpr int LDS_BYTES = 163840;

constexpr size_t MiB = 1u << 20;
constexpr size_t WS_CTL = 0, CTL_ZERO_BYTES = 128 * 1024;
constexpr size_t WS_ADA = 0, WS_ROWSQ = 16 * 1024, WS_BAR = 96 * 1024, WS_PCNT = 112 * 1024;
constexpr size_t WS_WIN = 1 * MiB;
constexpr size_t WS_WPP = 16 * MiB, WS_WPG = 18 * MiB, WS_WOUT = 20 * MiB, WS_POOLW = 22 * MiB;
constexpr size_t WS_LR = 23 * MiB;
constexpr size_t WS_LTOT = 25 * MiB;
constexpr size_t WS_PIN = 26 * MiB, WS_SPG = 58 * MiB, WS_Q = 90 * MiB, WS_K = 106 * MiB, WS_V = 122 * MiB, WS_SGG = 154 * MiB, WS_SBP = 186 * MiB, WS_SBG = 218 * MiB;
constexpr size_t WS_STATES = 26 * MiB;
constexpr size_t WS_WINP = 250 * MiB;
constexpr size_t WS_END = 252 * MiB;

__device__ __forceinline__ unsigned cvt_pk_bf16(float lo, float hi) { unsigned r; asm volatile("v_cvt_pk_bf16_f32 %0, %1, %2" : "=v"(r) : "v"(lo), "v"(hi)); return r; }
__device__ __forceinline__ float bflo(unsigned u) { return __builtin_bit_cast(float, u << 16); }
__device__ __forceinline__ float bfhi(unsigned u) { return __builtin_bit_cast(float, u & 0xffff0000u); }
__device__ __forceinline__ float bf1(bf16_t u) { return __builtin_bit_cast(float, (unsigned)u << 16); }
__device__ __forceinline__ float sigmoidf_(float x) { return __builtin_amdgcn_rcpf(1.f + __expf(-x)); }
__device__ __forceinline__ float wave_sum(float v) {
#pragma unroll
    for (int o = 1; o < 64; o <<= 1) v += __shfl_xor(v, o);
    return v;
}

namespace pg8 {
constexpr int BM = 256, BK = 64, HALF = 128, HTB = HALF * BK * 2, NXCD = 8, WGM = 8;
__host__ __device__ __forceinline__ int lds_byte(int r, int c) { const int st = (r >> 4) * 2 + (c >> 5), rr = r & 15, cc = c & 31, ob = rr * 64 + cc * 2; return st * 1024 + (ob ^ (((ob >> 9) & 1) << 5)); }
__host__ __device__ __forceinline__ void stage_rc(int b, int& R, int& C) { const int st = b / 1024, sb = b % 1024, swz = sb ^ (((sb >> 9) & 1) << 5); R = (st >> 1) * 16 + swz / 64; C = (st & 1) * 32 + (swz % 64) / 2; }
__host__ __device__ __forceinline__ int perm32(int rho) { const int n = rho >> 4, i = rho & 15; return 8 * (i >> 2) + 4 * n + (i & 3); }

struct Unit { int pm, pn, w; };
struct Gemm { const bf16_t* A; const bf16_t* Bt; int M, N, K, lda, a_pn_off, tr_lo, tr_hi, ldb, b_pm_off; };

struct StaticOrder {
    int nM, nN, nwg, G, c, rev, dual;
    __device__ void init(int M, int N, int G_, int c_, int rev_ = 0, int dual_ = 0) { nM = M / BM; nN = N / BM; nwg = nM * nN; G = G_; c = c_; rev = rev_; dual = dual_; }
    __device__ bool next(int i_, Unit& u) const {
        const int i = dual ? (i_ >> 1) : i_; u.w = dual ? (i_ & 1) : 0;
        const long L = (long)i * G + c; if (L >= nwg) return false;
        int wgid = (int)L; { const int q = nwg / NXCD, r = nwg % NXCD, xcd = wgid % NXCD, off = wgid / NXCD; wgid = (xcd < r ? xcd * (q + 1) : r * (q + 1) + (xcd - r) * q) + off; }
        const int nig = WGM * nN, gid = wgid / nig, fm = gid * WGM, gsz = (nM - fm) < WGM ? (nM - fm) : WGM;
        u.pm = fm + ((wgid % nig) % gsz); u.pn = (wgid % nig) / gsz; if (rev) u.pn = nN - 1 - u.pn; return true;
    }
};

template <class Epi>
__device__ __forceinline__ void gemm_phase(LAS unsigned char* lds, const Gemm g, const StaticOrder& S, const Epi& E) {
    const int tid = threadIdx.x, wid = __builtin_amdgcn_readfirstlane(tid >> 6), lane = tid & 63, wr = wid >> 2, wc = wid & 3, fr = lane & 15, fq = lane >> 4;
    const int K = g.K, nt = K / BK, lda = g.lda, ldb = g.ldb;
    unsigned voffA[2], voffB[2];
#pragma unroll
    for (int i = 0; i < 2; ++i) { int R, C; stage_rc(tid * 16 + i * 8192, R, C); const int Rb = (R & ~31) + perm32(R & 31);
        voffA[i] = (unsigned)(R * lda + C) * 2u; voffB[i] = (unsigned)(Rb * ldb + C) * 2u; }
    const size_t kstep = (size_t)(BK * 2);
    const size_t hstepA = (size_t)HALF * lda * 2, hstepB = (size_t)HALF * ldb * 2;
    const size_t tstepA = 2 * hstepA, tstepB = 2 * hstepB;
    const unsigned ldsw = (unsigned)wid * 1024u;
    const int aoff = lds_byte(wr * 64 + fr, fq * 8), boff = lds_byte(wc * 32 + fr, fq * 8);
#define PG8_SA(b, h) (((b) * 2 + (h)) * HTB)
#define PG8_SB(b, h) ((4 + (b) * 2 + (h)) * HTB)
#define PG8_STAGE(bufoff, gbase, voff) do { _Pragma("unroll") for (int _i = 0; _i < 2; ++_i) \
        __builtin_amdgcn_global_load_lds((const unsigned*)((const char*)(gbase) + (voff)[_i]), (LAS unsigned*)(lds + (bufoff) + ldsw + _i * 8192), 16, 0, 0); } while (0)
#define PG8_LDA(dst, b, h) do { _Pragma("unroll") for (int m = 0; m < 4; ++m) _Pragma("unroll") for (int k = 0; k < 2; ++k) dst[m][k] = *(const LAS bf16x8*)(lds + PG8_SA(b, h) + aoff + m * 2048 + k * 1024); } while (0)
#define PG8_LDB(dst, b, h) do { _Pragma("unroll") for (int n = 0; n < 2; ++n) _Pragma("unroll") for (int k = 0; k < 2; ++k) dst[n][k] = *(const LAS bf16x8*)(lds + PG8_SB(b, h) + boff + n * 2048 + k * 1024); } while (0)
#define PG8_MMA(ai, bj, At, Bt) do { __builtin_amdgcn_s_setprio(1); _Pragma("unroll") for (int m = 0; m < 4; ++m) _Pragma("unroll") for (int n = 0; n < 2; ++n) _Pragma("unroll") for (int k = 0; k < 2; ++k) \
        acc[ai][bj][m][n] = __builtin_amdgcn_mfma_f32_16x16x32_bf16(Bt[n][k], At[m][k], acc[ai][bj][m][n], 0, 0, 0); __builtin_amdgcn_s_setprio(0); } while (0)
#define PG8_WAIT_V(n) asm volatile("s_waitcnt vmcnt(" #n ")" ::: "memory")
#define PG8_WAIT_L(n) asm volatile("s_waitcnt lgkmcnt(" #n ")" ::: "memory")
#define PG8_BAR __builtin_amdgcn_s_barrier()
#define PG8_SCHED __builtin_amdgcn_sched_barrier(0)
    Unit cur, nxt; int ui = 0;
    if (!S.next(0, cur)) return;
    f32x4 acc[2][2][4][2];
#pragma unroll
    for (int a = 0; a < 2; ++a)
#pragma unroll
        for (int b = 0; b < 2; ++b)
#pragma unroll
            for (int m = 0; m < 4; ++m)
#pragma unroll
                for (int n = 0; n < 2; ++n) acc[a][b][m][n] = (f32x4){0.f, 0.f, 0.f, 0.f};
    bf16x8 At[4][2], B0[2][2], B1[2][2];
#define PG8_UPTR(u, pa, pb) do { if ((u).pn >= g.tr_lo && (u).pn < g.tr_hi) { pa = (const char*)g.Bt + (size_t)(u).pn * tstepB; pb = (const char*)g.A + (size_t)(u).pm * tstepA; } \
        else if ((u).w) { const char* ws_ = *(const char* const __attribute__((address_space(4)))*)((const __attribute__((address_space(4))) unsigned char*)__builtin_amdgcn_kernarg_segment_ptr() + 144);     \
            pa = ws_ + WS_SGG + (size_t)(u).pm * tstepA; pb = ws_ + WS_WPG + (size_t)(u).pn * tstepB; } \
        else { pa = (const char*)g.A + (size_t)(u).pm * tstepA + (size_t)(u).pn * g.a_pn_off * 2; pb = (const char*)g.Bt + (size_t)(u).pn * tstepB + (size_t)(u).pm * g.b_pm_off * 2; } } while (0)
    const char* cA; const char* cB; PG8_UPTR(cur, cA, cB);
    PG8_STAGE(PG8_SB(0, 0), cB, voffB); PG8_STAGE(PG8_SB(0, 1), cB + hstepB, voffB); PG8_STAGE(PG8_SA(0, 0), cA, voffA); PG8_STAGE(PG8_SA(0, 1), cA + hstepA, voffA);
    if (wr == 1) PG8_BAR;
    PG8_WAIT_V(2); PG8_BAR;
    PG8_STAGE(PG8_SB(1, 0), cB + kstep, voffB); PG8_STAGE(PG8_SA(1, 0), cA + kstep, voffA); PG8_STAGE(PG8_SB(1, 1), cB + hstepB + kstep, voffB);
    PG8_WAIT_V(6); PG8_BAR;
    for (;;) {
        const bool has_next = S.next(ui + 1, nxt);
        const char* nA = cA; const char* nB = cB; if (has_next) PG8_UPTR(nxt, nA, nB);
        for (int t = 0; t < nt; t += 2) {
            const bool last = (t == nt - 2);
            const char* a1 = cA + (size_t)(t + 1) * kstep;
            const char* a2 = last ? nA : cA + (size_t)(t + 2) * kstep; const char* b2 = last ? nB : cB + (size_t)(t + 2) * kstep;
            const char* a3 = a2 + kstep; const char* b3 = b2 + kstep;
            PG8_LDB(B0, 0, 0); PG8_LDB(B1, 0, 1); PG8_SCHED; PG8_LDA(At, 0, 0); PG8_STAGE(PG8_SA(1, 1), a1 + hstepA, voffA);
            PG8_WAIT_V(8); PG8_WAIT_L(0); PG8_BAR; PG8_MMA(0, 0, At, B0); PG8_MMA(0, 1, At, B1); PG8_BAR; PG8_SCHED;
            PG8_LDA(At, 0, 1); PG8_STAGE(PG8_SB(0, 0), b2, voffB); PG8_STAGE(PG8_SB(0, 1), b2 + hstepB, voffB); PG8_STAGE(PG8_SA(0, 0), a2, voffA);
            PG8_WAIT_V(8); PG8_WAIT_L(0); PG8_BAR; PG8_MMA(1, 0, At, B0); PG8_MMA(1, 1, At, B1); PG8_BAR; PG8_SCHED;
            PG8_LDB(B0, 1, 0); PG8_LDB(B1, 1, 1); PG8_SCHED; PG8_LDA(At, 1, 0); PG8_STAGE(PG8_SA(0, 1), a2 + hstepA, voffA);
            PG8_WAIT_V(8); PG8_WAIT_L(0); PG8_BAR; PG8_MMA(0, 0, At, B0); PG8_MMA(0, 1, At, B1); PG8_BAR; PG8_SCHED;
            PG8_LDA(At, 1, 1); PG8_STAGE(PG8_SB(1, 0), b3, voffB); PG8_STAGE(PG8_SB(1, 1), b3 + hstepB, voffB); PG8_STAGE(PG8_SA(1, 0), a3, voffA);
            PG8_WAIT_V(8); PG8_WAIT_L(0); PG8_BAR; PG8_MMA(1, 0, At, B0); PG8_MMA(1, 1, At, B1); PG8_BAR; PG8_SCHED;
        }
        if (wr == 0) PG8_BAR;
        E(acc, cur, wr, wc, fr, fq);
        if (!has_next) break;
#pragma unroll
        for (int a = 0; a < 2; ++a)
#pragma unroll
            for (int b = 0; b < 2; ++b)
#pragma unroll
                for (int m = 0; m < 4; ++m)
#pragma unroll
                    for (int n = 0; n < 2; ++n) acc[a][b][m][n] = (f32x4){0.f, 0.f, 0.f, 0.f};
        cur = nxt; cA = nA; cB = nB; ++ui;
        if (wr == 1) PG8_BAR;
    }
    PG8_WAIT_V(0);
    PG8_BAR;
#undef PG8_UPTR
#undef PG8_SA
#undef PG8_SB
#undef PG8_STAGE
#undef PG8_LDA
#undef PG8_LDB
#undef PG8_MMA
#undef PG8_WAIT_V
#undef PG8_WAIT_L
#undef PG8_BAR
#undef PG8_SCHED
}

__device__ __forceinline__ u32x4 pack8(f32x4 v0, f32x4 v1) { u32x4 w; w.x = cvt_pk_bf16(v0[0], v0[1]); w.y = cvt_pk_bf16(v0[2], v0[3]); w.z = cvt_pk_bf16(v1[0], v1[1]); w.w = cvt_pk_bf16(v1[2], v1[3]); return w; }
__device__ __forceinline__ void unpack8(u32x4 w, f32x4& v0, f32x4& v1) { v0 = (f32x4){bflo(w.x), bfhi(w.x), bflo(w.y), bfhi(w.y)}; v1 = (f32x4){bflo(w.z), bfhi(w.z), bflo(w.w), bfhi(w.w)}; }

struct EpiProj {
    unsigned char* ws; bf16_t* kt;
    __device__ __forceinline__ void operator()(const f32x4 (&acc)[2][2][4][2], const Unit& u, int wr, int wc, int fr, int fq) const {
        const int t = u.pn;
        if (t >= 12 && t < 16) {
            bf16_t* vt = (bf16_t*)(ws + WS_V);
            const int vrow0 = (t - 12) * 256 + wr * 64 + fr, tok0 = u.pm * BM + wc * 32 + 8 * fq;
#pragma unroll
            for (int ai = 0; ai < 2; ++ai)
#pragma unroll
                for (int m = 0; m < 4; ++m) { const int vrow = vrow0 + ai * HALF + m * 16;
#pragma unroll
                    for (int bj = 0; bj < 2; ++bj) { const int tok = tok0 + bj * HALF;
                        *(u32x4*)(vt + ((size_t)(tok >> 6) * 1024 + vrow) * 64 + (tok & 63)) = pack8(acc[ai][bj][m][0], acc[ai][bj][m][1]); } }
            return;
        }
        size_t off; int pitch, colt, act; float sc = 1.f;
        if (t < 4)       { off = WS_PIN; pitch = D;  colt = t * 256;        act = 0; }
        else if (t < 8)  { off = WS_SPG; pitch = D;  colt = (t - 4) * 256;  act = 1; }
        else if (t < 10) { off = WS_Q;   pitch = KW; colt = (t - 8) * 256;  act = 0; sc = 0.08838834764831845f; }
        else if (t < 12) { off = WS_K;   pitch = KW; colt = (t - 10) * 256; act = 0; }
        else if (t < 20) { off = WS_SGG; pitch = D;  colt = (t - 16) * 256; act = 1; }
        else if (t < 24) { off = WS_SBP; pitch = D;  colt = (t - 20) * 256; act = 2; }
        else             { off = WS_SBG; pitch = D;  colt = (t - 24) * 256; act = 2; }
        bf16_t* base = (bf16_t*)(ws + off);
        const int row0 = u.pm * BM + wr * 64 + fr, col0 = colt + wc * 32 + 8 * fq;
#pragma unroll
        for (int ai = 0; ai < 2; ++ai)
#pragma unroll
            for (int m = 0; m < 4; ++m) { bf16_t* rowp = base + (size_t)(row0 + ai * HALF + m * 16) * pitch + col0;
#pragma unroll
                for (int bj = 0; bj < 2; ++bj) { f32x4 v0 = acc[ai][bj][m][0], v1 = acc[ai][bj][m][1];
                    if (act == 1) {
#pragma unroll
                        for (int e = 0; e < 4; ++e) { v0[e] = v0[e] * sigmoidf_(v0[e]); v1[e] = v1[e] * sigmoidf_(v1[e]); }
                    } else if (act == 2) {
#pragma unroll
                        for (int e = 0; e < 4; ++e) { v0[e] = sigmoidf_(v0[e]); v1[e] = sigmoidf_(v1[e]); }
                    } else { v0 = v0 * sc; v1 = v1 * sc; }
                    *(u32x4*)(rowp + bj * HALF) = pack8(v0, v1); } }
        if (t >= 10 && t < 12) {
#pragma unroll
            for (int ai = 0; ai < 2; ++ai)
#pragma unroll
                for (int m = 0; m < 4; ++m) { const int row = row0 + ai * HALF + m * 16; bf16_t* cp = kt + ((size_t)(row >> 6) * 512 + col0) * 64 + (row & 63);
#pragma unroll
                    for (int bj = 0; bj < 2; ++bj) { const u32x4 pk = pack8(acc[ai][bj][m][0], acc[ai][bj][m][1]); bf16_t* cq = cp + (bj * HALF) * 64;
                        cq[0] = (bf16_t)(pk.x & 0xffffu); cq[1 * 64] = (bf16_t)(pk.x >> 16); cq[2 * 64] = (bf16_t)(pk.y & 0xffffu); cq[3 * 64] = (bf16_t)(pk.y >> 16);
                        cq[4 * 64] = (bf16_t)(pk.z & 0xffffu); cq[5 * 64] = (bf16_t)(pk.z >> 16); cq[6 * 64] = (bf16_t)(pk.w & 0xffffu); cq[7 * 64] = (bf16_t)(pk.w >> 16); } }
        }
    }
};
struct EpiFold {
    bf16_t* win; const float* pscale;
    __device__ __forceinline__ void operator()(const f32x4 (&acc)[2][2][4][2], const Unit& u, int wr, int wc, int fr, int fq) const {
        const int row0 = u.pm * BM + wr * 64 + fr, col0 = u.pn * BM + wc * 32 + 8 * fq;
        float psv[2][4];
#pragma unroll
        for (int ai = 0; ai < 2; ++ai)
#pragma unroll
            for (int m = 0; m < 4; ++m) psv[ai][m] = pscale[row0 + ai * HALF + m * 16];
#pragma unroll
        for (int ai = 0; ai < 2; ++ai)
#pragma unroll
            for (int m = 0; m < 4; ++m) { const int row = row0 + ai * HALF + m * 16; const float ps = psv[ai][m];
#pragma unroll
                for (int bj = 0; bj < 2; ++bj) *(u32x4*)(win + (size_t)row * D + col0 + bj * HALF) = pack8(acc[ai][bj][m][0] * ps, acc[ai][bj][m][1] * ps); }
    }
};
struct EpiYPool {
    bf16_t* sbp;
    __device__ __forceinline__ void operator()(const f32x4 (&acc)[2][2][4][2], const Unit& u, int wr, int wc, int fr, int fq) const {
        const int row0 = u.pm * BM + wr * 64 + fr, col0 = u.pn * BM + wc * 32 + 8 * fq;
#pragma unroll
        for (int ai = 0; ai < 2; ++ai) { u32x4 gv[4][2];
#pragma unroll
            for (int m = 0; m < 4; ++m)
#pragma unroll
                for (int bj = 0; bj < 2; ++bj) gv[m][bj] = *(const u32x4*)(sbp + (size_t)(row0 + ai * HALF + m * 16) * D + col0 + bj * HALF);
#pragma unroll
            for (int m = 0; m < 4; ++m)
#pragma unroll
                for (int bj = 0; bj < 2; ++bj) { f32x4 g0, g1; unpack8(gv[m][bj], g0, g1);
                    *(u32x4*)(sbp + (size_t)(row0 + ai * HALF + m * 16) * D + col0 + bj * HALF) = pack8(acc[ai][bj][m][0] * g0, acc[ai][bj][m][1] * g1); } }
    }
};
struct EpiYGla {
    const bf16_t* sbp; bf16_t* sbg;
    __device__ __forceinline__ void operator()(const f32x4 (&acc)[2][2][4][2], const Unit& u, int wr, int wc, int fr, int fq) const {
        const int row0 = u.pm * BM + wr * 64 + fr, col0 = u.pn * BM + wc * 32 + 8 * fq;
#pragma unroll
        for (int ai = 0; ai < 2; ++ai) { u32x4 gv[4][2], pv[4][2];
#pragma unroll
            for (int m = 0; m < 4; ++m)
#pragma unroll
                for (int bj = 0; bj < 2; ++bj) { const size_t ro = (size_t)(row0 + ai * HALF + m * 16) * D + col0 + bj * HALF; gv[m][bj] = *(const u32x4*)(sbg + ro); pv[m][bj] = *(const u32x4*)(sbp + ro); }
#pragma unroll
            for (int m = 0; m < 4; ++m)
#pragma unroll
                for (int bj = 0; bj < 2; ++bj) { const size_t ro = (size_t)(row0 + ai * HALF + m * 16) * D + col0 + bj * HALF; f32x4 g0, g1, p0, p1; unpack8(gv[m][bj], g0, g1); unpack8(pv[m][bj], p0, p1);
                    *(u32x4*)(sbg + ro) = pack8(p0 + acc[ai][bj][m][0] * g0, p1 + acc[ai][bj][m][1] * g1); } }
    }
};
struct EpiDual {
    EpiYPool e0; EpiYGla e1;
    __device__ __forceinline__ void operator()(const f32x4 (&acc)[2][2][4][2], const Unit& u, int wr, int wc, int fr, int fq) const {
        if (u.w == 0) e0(acc, u, wr, wc, fr, fq); else e1(acc, u, wr, wc, fr, fq);
    }
};
struct EpiOutFused {
    const float* x; float* y; float* rowsq; unsigned* pcnt; const float* adaacc; const float* b_ada; const float* g_post;
    __device__ __forceinline__ void operator()(const f32x4 (&acc)[2][2][4][2], const Unit& u, int wr, int wc, int fr, int fq) const {
        const int row0 = u.pm * BM + wr * 64 + fr, col0 = u.pn * BM + wc * 32 + 8 * fq;
#pragma unroll
        for (int ai = 0; ai < 2; ++ai)
#pragma unroll
            for (int m = 0; m < 4; ++m) { const int row = row0 + ai * HALF + m * 16; float ss = 0.f;
#pragma unroll
                for (int bj = 0; bj < 2; ++bj) { const f32x4 v0 = acc[ai][bj][m][0], v1 = acc[ai][bj][m][1];
                    ss += (v0[0] * v0[0] + v0[1] * v0[1]) + (v0[2] * v0[2] + v0[3] * v0[3]) + (v1[0] * v1[0] + v1[1] * v1[1]) + (v1[2] * v1[2] + v1[3] * v1[3]); }
                ss += __shfl_xor(ss, 16); ss += __shfl_xor(ss, 32);
                if (fq == 0) atomicAdd(rowsq + row, ss); }
        asm volatile("s_waitcnt vmcnt(0)" ::: "memory");
        __syncthreads();
        if (threadIdx.x == 0) {
            __hip_atomic_fetch_add(pcnt + u.pm, 1u, __ATOMIC_RELAXED, __HIP_MEMORY_SCOPE_AGENT);
            unsigned sp = 0;
            while (__hip_atomic_load(pcnt + u.pm, __ATOMIC_RELAXED, __HIP_MEMORY_SCOPE_AGENT) < 4u) { __builtin_amdgcn_s_sleep(1); if (++sp > (1u << 22)) break; }
        }
        __syncthreads();
        f32x4 gg[2][2];
#pragma unroll
        for (int bj = 0; bj < 2; ++bj)
#pragma unroll
            for (int n = 0; n < 2; ++n) { const int c = col0 + bj * HALF + 4 * n;
                gg[bj][n] = (*(const f32x4*)(adaacc + 2 * D + c) + *(const f32x4*)(b_ada + 2 * D + c)) * *(const f32x4*)(g_post + c); }
        float rs[2][4];
#pragma unroll
        for (int ai = 0; ai < 2; ++ai)
#pragma unroll
            for (int m = 0; m < 4; ++m) rs[ai][m] = __hip_atomic_load(rowsq + row0 + ai * HALF + m * 16, __ATOMIC_RELAXED, __HIP_MEMORY_SCOPE_AGENT);
#pragma unroll
        for (int ai = 0; ai < 2; ++ai) { f32x4 xv[4][2][2];
#pragma unroll
            for (int m = 0; m < 4; ++m) { const float* xr = x + (size_t)(row0 + ai * HALF + m * 16) * D + col0;
#pragma unroll
                for (int bj = 0; bj < 2; ++bj) { xv[m][bj][0] = *(const f32x4*)(xr + bj * HALF); xv[m][bj][1] = *(const f32x4*)(xr + bj * HALF + 4); } }
#pragma unroll
            for (int m = 0; m < 4; ++m) { const float rstd = __builtin_amdgcn_rsqf(rs[ai][m] * (1.f / D) + RMS_EPS);
                float* yr = y + (size_t)(row0 + ai * HALF + m * 16) * D + col0;
#pragma unroll
                for (int bj = 0; bj < 2; ++bj) {
                    *(f32x4*)(yr + bj * HALF) = xv[m][bj][0] + gg[bj][0] * (acc[ai][bj][m][0] * rstd); *(f32x4*)(yr + bj * HALF + 4) = xv[m][bj][1] + gg[bj][1] * (acc[ai][bj][m][1] * rstd); } } }
    }
};
}

__device__ __forceinline__ void transpose_item(const float* W, int K, int N, bf16_t* WT, int k0, int n0, int drow, LAS float* scr, int lane) {
    float tv[32];
#pragma unroll
    for (int i = 0; i < 32; ++i) { const int kk = 2 * i + (lane >> 5); tv[i] = W[(size_t)(k0 + kk) * N + n0 + (lane & 31)]; }
#pragma unroll
    for (int i = 0; i < 32; ++i) { const int kk = 2 * i + (lane >> 5); scr[kk * 33 + (lane & 31)] = tv[i]; }
    asm volatile("s_waitcnt lgkmcnt(0)" ::: "memory");
    const int c = lane & 7;
#pragma unroll
    for (int j = 0; j < 4; ++j) { const int n = (lane >> 3) + 8 * j; const LAS float* s = scr + (8 * c) * 33 + n;
        u32x4 o; o.x = cvt_pk_bf16(s[0 * 33], s[1 * 33]); o.y = cvt_pk_bf16(s[2 * 33], s[3 * 33]); o.z = cvt_pk_bf16(s[4 * 33], s[5 * 33]); o.w = cvt_pk_bf16(s[6 * 33], s[7 * 33]);
        *(u32x4*)(WT + (size_t)(drow + n) * K + k0 + 8 * c) = o; }
    asm volatile("s_waitcnt lgkmcnt(0)" ::: "memory");
}

constexpr int P_QD = 272, P_T = 144, P_CUM = 528, P_O = 528, P_LR = 144;
constexpr int L_QD = 0, L_KI = L_QD + 64 * P_QD, L_KET = L_KI + 64 * P_QD, L_VT = L_KET + 128 * P_T, L_SC = L_VT + 256 * P_T, L_DEC = L_SC + 64 * P_T,
              L_LR = L_DEC + 512, L_CUM = L_LR + 64 * P_LR, L_GN = L_CUM + 64 * P_CUM, L_GLA_END = L_GN + 1024, L_OT = L_CUM;
static_assert(L_GLA_END <= LDS_BYTES - 256 && P_O <= P_CUM, "GLA LDS map");

#define LBAR() asm volatile("s_waitcnt lgkmcnt(0)\n\ts_barrier" ::: "memory")

__device__ __forceinline__ void gla_load_a(const int tid, const int row0, const int h, const bf16_t* __restrict__ VT, const float* __restrict__ LR, f32x4& lr4, u32x4 (&vt4)[4]) {
    lr4 = ((const f32x4*)(LR + (size_t)row0 * 32))[tid];
    const bf16_t* vsrc = VT + ((size_t)(row0 >> 6) * 1024 + h * HV) * 64;
#pragma unroll
    for (int i = 0; i < 4; ++i) vt4[i] = *(const u32x4*)(vsrc + (size_t)(tid + 512 * i) * 8);
}
template <bool NEED_O>
__device__ __forceinline__ void gla_load_b(const int tid, const int row0, const int h,
        const bf16_t* __restrict__ Qb, const bf16_t* __restrict__ Kb, const bf16_t* __restrict__ KT, u32x2 (&ktv)[4], u32x4 (&qg)[2], u32x4 (&kg)[2]) {
    const int frow = tid >> 3, fc8 = tid & 7;
    { const bf16_t* ksrc = KT + ((size_t)(row0 >> 6) * 512 + h * HK + 16 * (tid >> 6) + (tid & 15)) * 64 + ((tid & 63) >> 4) * 4;
#pragma unroll
      for (int t = 0; t < 4; ++t) ktv[t] = *(const u32x2*)(ksrc + 16 * t); }
    if (NEED_O) {
#pragma unroll
        for (int hf = 0; hf < 2; ++hf) { const int dk0 = fc8 * 8 + hf * 64;
            qg[hf] = *(const u32x4*)(Qb + (size_t)(row0 + frow) * KW + h * HK + dk0); kg[hf] = *(const u32x4*)(Kb + (size_t)(row0 + frow) * KW + h * HK + dk0); }
    }
}
template <bool NEED_O>
__device__ __forceinline__ void gla_load(const int tid, const int row0, const int h,
        const bf16_t* __restrict__ Qb, const bf16_t* __restrict__ Kb, const bf16_t* __restrict__ KT, const bf16_t* __restrict__ VT, const float* __restrict__ LR,
        f32x4& lr4, u32x4 (&vt4)[4], u32x2 (&ktv)[4], u32x4 (&qg)[2], u32x4 (&kg)[2]) {
    gla_load_a(tid, row0, h, VT, LR, lr4, vt4); gla_load_b<NEED_O>(tid, row0, h, Qb, Kb, KT, ktv, qg, kg);
}

template <bool NEED_O>
__device__ __forceinline__ void gla_chunk(LAS unsigned char* lds, const int tid_in, const int row0, const int row0_next, const int h, const int dir,
        const bf16_t* __restrict__ Qb, const bf16_t* __restrict__ Kb, const bf16_t* __restrict__ KT, const bf16_t* __restrict__ VT, const float* __restrict__ LR,
        const bf16x8 ub1, const bf16x8 ub2, const float bias, f32x4 (&St)[8][2], float& ltot,
        bf16_t* OFb, bf16_t* SGG, const float* __restrict__ gnorm,
        f32x4& lr4, u32x4 (&vt4)[4], u32x2 (&ktv)[4], u32x4 (&qg)[2], u32x4 (&kg)[2]) {
    int tid = tid_in; asm volatile("" : "+v"(tid));
    const int w = __builtin_amdgcn_readfirstlane(tid >> 6);
    const int frow = tid >> 3, fc8 = tid & 7;
    const size_t gi = (size_t)(row0 + frow) * D + h * HV + fc8 * 32;
    u32x4 ofg[4], sgg[4];
    if (NEED_O) {
        if (dir == 1) {
#pragma unroll
            for (int q = 0; q < 4; ++q) { ofg[q] = *(const u32x4*)(OFb + gi + q * 8); sgg[q] = *(const u32x4*)(SGG + gi + q * 8); }
        }
    }
    LBAR();
    {
        const int row = tid >> 3, c4 = (tid & 7) * 4, dsel = c4 >> 4, c = c4 & 15;
        const unsigned h01 = cvt_pk_bf16(lr4[0], lr4[1]), h23 = cvt_pk_bf16(lr4[2], lr4[3]);
        const unsigned l01 = cvt_pk_bf16(lr4[0] - bflo(h01), lr4[1] - bfhi(h01)), l23 = cvt_pk_bf16(lr4[2] - bflo(h23), lr4[3] - bfhi(h23));
        LAS unsigned char* lp = lds + L_LR + row * P_LR + dsel * 64 + c * 2;
        *(LAS u32x2*)lp = (u32x2){h01, h23}; *(LAS u32x2*)(lp + 32) = (u32x2){l01, l23};
    }
#pragma unroll
    for (int i = 0; i < 4; ++i) { const int p = tid + 512 * i, dvr = p >> 3, c = p & 7; *(LAS u32x4*)(lds + L_VT + dvr * P_T + c * 16) = vt4[i]; }
    gla_load_a(tid, row0_next, h, VT, LR, lr4, vt4);
    LBAR();
    {
        const int fr0 = tid & 15, fq0 = (tid & 63) >> 4, dl = 16 * w + fr0;
        const LAS unsigned char* ab = lds + L_LR + fr0 * P_LR + dir * 64 + fq0 * 16;
        f32x4 la[4], cumv[4]; float exc[4], T[4];
#pragma unroll
        for (int t = 0; t < 4; ++t) { const bf16x8 af = *(const LAS bf16x8*)(ab + t * 16 * P_LR);
            f32x4 z = __builtin_amdgcn_mfma_f32_16x16x32_bf16(af, ub1, (f32x4){0.f, 0.f, 0.f, 0.f}, 0, 0, 0); z = __builtin_amdgcn_mfma_f32_16x16x32_bf16(af, ub2, z, 0, 0, 0);
#pragma unroll
            for (int jj = 0; jj < 4; ++jj) { const float zz = z[jj] + bias; la[t][jj] = (fminf(zz, 0.f) - __logf(1.f + __expf(-fabsf(zz)))) * (1.f / 16.f); } }
#pragma unroll
        for (int t = 0; t < 4; ++t) { cumv[t][0] = la[t][0]; cumv[t][1] = cumv[t][0] + la[t][1]; cumv[t][2] = cumv[t][1] + la[t][2]; cumv[t][3] = cumv[t][2] + la[t][3];
            const float g = cumv[t][3]; float inc = g; float y = __shfl_up(inc, 16); if (fq0 >= 1) inc += y; y = __shfl_up(inc, 32); if (fq0 >= 2) inc += y;
            exc[t] = inc - g; T[t] = __shfl(inc, fr0 + 48); }
        float off = 0.f;
#pragma unroll
        for (int t = 0; t < 4; ++t) { const float o2 = off + exc[t]; cumv[t] = cumv[t] + o2; off += T[t]; }
        const float tot = off;
        if (dir == 1) {
#pragma unroll
            for (int t = 0; t < 4; ++t) cumv[t] = (la[t] - cumv[t]) + tot;
        }
        if (fq0 == 0) { ((LAS float*)(lds + L_DEC))[dl] = __expf(tot); ltot += tot; }
        LAS unsigned char* kt = lds + L_KET + dl * P_T + fq0 * 8;
#pragma unroll
        for (int t = 0; t < 4; ++t) { const f32x4 k4 = (f32x4){bflo(ktv[t].x), bfhi(ktv[t].x), bflo(ktv[t].y), bfhi(ktv[t].y)}; f32x4 ke;
#pragma unroll
            for (int jj = 0; jj < 4; ++jj) { ke[jj] = k4[jj] * __expf(tot - cumv[t][jj]);
                if (NEED_O) *(LAS float*)(lds + L_CUM + (16 * t + 4 * fq0 + jj) * P_CUM + dl * 4) = cumv[t][jj]; }
            *(LAS u32x2*)(kt + t * 32) = (u32x2){cvt_pk_bf16(ke[0], ke[1]), cvt_pk_bf16(ke[2], ke[3])}; }
    }
    if (NEED_O) {
        LBAR();
        const int row = tid >> 3, c8 = tid & 7;
#pragma unroll
        for (int hf = 0; hf < 2; ++hf) { const int dk0 = c8 * 8 + hf * 64;
            f32x4 q0, q1, k0, k1; pg8::unpack8(qg[hf], q0, q1); pg8::unpack8(kg[hf], k0, k1);
            const f32x4 c0 = *(const LAS f32x4*)(lds + L_CUM + row * P_CUM + dk0 * 4), c1 = *(const LAS f32x4*)(lds + L_CUM + row * P_CUM + dk0 * 4 + 16);
#pragma unroll
            for (int e = 0; e < 4; ++e) { q0[e] *= __expf(c0[e]); q1[e] *= __expf(c1[e]); k0[e] *= __expf(-c0[e]); k1[e] *= __expf(-c1[e]); }
            *(LAS u32x4*)(lds + L_QD + row * P_QD + dk0 * 2) = pg8::pack8(q0, q1);
            *(LAS u32x4*)(lds + L_KI + row * P_QD + dk0 * 2) = pg8::pack8(k0, k1); }
    }
    gla_load_b<NEED_O>(tid, row0_next, h, Qb, Kb, KT, ktv, qg, kg);
    LBAR();
    asm volatile("" : "+v"(tid));
    const int fr = tid & 15, fq = (tid & 63) >> 4;
    if (NEED_O) {
        {
            const int it = w >> 1, jt0 = (w & 1) * 2;
            f32x4 p[2] = {(f32x4){0.f, 0.f, 0.f, 0.f}, (f32x4){0.f, 0.f, 0.f, 0.f}};
            const LAS unsigned char* qb_ = lds + L_QD + fr * P_QD + fq * 16 + it * 16 * P_QD;
            const LAS unsigned char* kb_ = lds + L_KI + fr * P_QD + fq * 16 + jt0 * 16 * P_QD;
#pragma unroll
            for (int ks = 0; ks < 4; ++ks) {
                const bf16x8 qf = *(const LAS bf16x8*)(qb_ + ks * 64);
#pragma unroll
                for (int t = 0; t < 2; ++t) { const bf16x8 kf = *(const LAS bf16x8*)(kb_ + t * 16 * P_QD + ks * 64);
                    p[t] = __builtin_amdgcn_mfma_f32_16x16x32_bf16(kf, qf, p[t], 0, 0, 0); } }
            LAS unsigned char* sw = lds + L_SC + (it * 16 + fr) * P_T + (jt0 * 16 + fq * 4) * 2;
#pragma unroll
            for (int t = 0; t < 2; ++t) { const int i = it * 16 + fr, jb = (jt0 + t) * 16 + fq * 4; float v[4];
#pragma unroll
                for (int jj = 0; jj < 4; ++jj) { const int j = jb + jj; const bool keep = (dir == 0) ? (j <= i) : (j > i); v[jj] = keep ? p[t][jj] : 0.f; }
                *(LAS u32x2*)(sw + t * 32) = (u32x2){cvt_pk_bf16(v[0], v[1]), cvt_pk_bf16(v[2], v[3])}; }
        }
        LBAR();
        f32x4 o[4][2];
#pragma unroll
        for (int a = 0; a < 4; ++a) { o[a][0] = (f32x4){0.f, 0.f, 0.f, 0.f}; o[a][1] = (f32x4){0.f, 0.f, 0.f, 0.f}; }
        {
            const LAS unsigned char* vb_ = lds + L_VT + ((2 * w) * 16 + fr) * P_T + fq * 16;
            const LAS unsigned char* sb_ = lds + L_SC + fr * P_T + fq * 16;
#pragma unroll
            for (int ks = 0; ks < 2; ++ks) { bf16x8 vf[2];
#pragma unroll
                for (int bb = 0; bb < 2; ++bb) vf[bb] = *(const LAS bf16x8*)(vb_ + bb * 16 * P_T + ks * 64);
#pragma unroll
                for (int a = 0; a < 4; ++a) { const bf16x8 sf = *(const LAS bf16x8*)(sb_ + a * 16 * P_T + ks * 64);
#pragma unroll
                    for (int bb = 0; bb < 2; ++bb) o[a][bb] = __builtin_amdgcn_mfma_f32_16x16x32_bf16(sf, vf[bb], o[a][bb], 0, 0, 0); } }
            const LAS unsigned char* qa_ = lds + L_QD + fr * P_QD + fq * 8;
#pragma unroll
            for (int p = 0; p < 4; ++p) { bf16x8 sb[2];
#pragma unroll
                for (int bb = 0; bb < 2; ++bb) { const f32x4 s0 = St[2 * p][bb], s1 = St[2 * p + 1][bb];
                    const u32x4 pk = (u32x4){cvt_pk_bf16(s0[0], s0[1]), cvt_pk_bf16(s0[2], s0[3]), cvt_pk_bf16(s1[0], s1[1]), cvt_pk_bf16(s1[2], s1[3])};
                    sb[bb] = __builtin_bit_cast(bf16x8, pk); }
#pragma unroll
                for (int a = 0; a < 4; ++a) {
                    const u32x2 lo = *(const LAS u32x2*)(qa_ + a * 16 * P_QD + p * 64), hi = *(const LAS u32x2*)(qa_ + a * 16 * P_QD + p * 64 + 32);
                    const bf16x8 qa = __builtin_bit_cast(bf16x8, (u32x4){lo.x, lo.y, hi.x, hi.y});
#pragma unroll
                    for (int bb = 0; bb < 2; ++bb) o[a][bb] = __builtin_amdgcn_mfma_f32_16x16x32_bf16(qa, sb[bb], o[a][bb], 0, 0, 0); }
                __builtin_amdgcn_sched_barrier(0); }
        }
        {
            LAS unsigned char* ot = lds + L_OT + (fq * 4) * P_O + ((2 * w) * 16 + fr) * 2;
#pragma unroll
            for (int a = 0; a < 4; ++a)
#pragma unroll
                for (int jj = 0; jj < 4; ++jj) {
                    *(LAS bf16_t*)(ot + (a * 16 + jj) * P_O) = (bf16_t)(cvt_pk_bf16(o[a][0][jj], 0.f) & 0xffffu);
                    *(LAS bf16_t*)(ot + (a * 16 + jj) * P_O + 32) = (bf16_t)(cvt_pk_bf16(o[a][1][jj], 0.f) & 0xffffu); }
        }
        LBAR();
        {
            const int row = tid >> 3, c8 = tid & 7;
            const LAS unsigned char* orow = lds + L_OT + row * P_O + c8 * 64;
            if (dir == 0) {
#pragma unroll
                for (int q = 0; q < 4; ++q) *(u32x4*)(OFb + gi + q * 8) = *(const LAS u32x4*)(orow + q * 16);
            } else {
                f32x4 val[8]; float ss = 0.f;
#pragma unroll
                for (int q = 0; q < 4; ++q) { f32x4 a0, a1, b0, b1; pg8::unpack8(*(const LAS u32x4*)(orow + q * 16), a0, a1); pg8::unpack8(ofg[q], b0, b1);
                    val[2 * q] = a0 + b0; val[2 * q + 1] = a1 + b1;
#pragma unroll
                    for (int e = 0; e < 4; ++e) ss += val[2 * q][e] * val[2 * q][e] + val[2 * q + 1][e] * val[2 * q + 1][e]; }
                ss += __shfl_xor(ss, 1); ss += __shfl_xor(ss, 2); ss += __shfl_xor(ss, 4);
                const float rstd = __builtin_amdgcn_rsqf(ss * (1.f / HV) + RMS_EPS);
#pragma unroll
                for (int q = 0; q < 4; ++q) { f32x4 g0, g1; pg8::unpack8(sgg[q], g0, g1);
                    const f32x4 n0 = *(const LAS f32x4*)(lds + L_GN + (c8 * 32 + q * 8) * 4), n1 = *(const LAS f32x4*)(lds + L_GN + (c8 * 32 + q * 8) * 4 + 16);
                    *(u32x4*)(SGG + gi + q * 8) = pg8::pack8(val[2 * q] * rstd * n0 * g0, val[2 * q + 1] * rstd * n1 * g1); }
            }
        }
    }
    if (!NEED_O || row0_next != row0) {
        const LAS unsigned char* dp = lds + L_DEC + fq * 16;
#pragma unroll
        for (int a = 0; a < 8; ++a) { const f32x4 dc = *(const LAS f32x4*)(dp + a * 64); St[a][0] *= dc; St[a][1] *= dc; }
        const LAS unsigned char* vb_ = lds + L_VT + ((2 * w) * 16 + fr) * P_T + fq * 16;
        const LAS unsigned char* kb_ = lds + L_KET + fr * P_T + fq * 16;
#pragma unroll
        for (int ks = 0; ks < 2; ++ks) { bf16x8 vf[2];
#pragma unroll
            for (int bb = 0; bb < 2; ++bb) vf[bb] = *(const LAS bf16x8*)(vb_ + bb * 16 * P_T + ks * 64);
#pragma unroll
            for (int a = 0; a < 8; ++a) { const bf16x8 kf = *(const LAS bf16x8*)(kb_ + a * 16 * P_T + ks * 64);
#pragma unroll
                for (int bb = 0; bb < 2; ++bb) St[a][bb] = __builtin_amdgcn_mfma_f32_16x16x32_bf16(kf, vf[bb], St[a][bb], 0, 0, 0); } }
    }
}

#define XB_TMO      128
#define XB_XCNT(j)  (256  + 64 * (j))
#define XB_XSUB(j)  (1280 + 64 * (j))
#define XB_XGEN(j)  (2304 + 64 * (j))
#define XB_TOP      3328
#define XB_TOPGEN   3392
#define XCD_BAR_WORDS 3456
#define XB_SPIN_CAP (1u << 18)
__device__ __forceinline__ unsigned xb_ld(unsigned* p)              { return __hip_atomic_load(p, __ATOMIC_RELAXED, __HIP_MEMORY_SCOPE_AGENT); }
__device__ __forceinline__ unsigned xb_add(unsigned* p, unsigned v) { return __hip_atomic_fetch_add(p, v, __ATOMIC_RELAXED, __HIP_MEMORY_SCOPE_AGENT); }
__device__ __forceinline__ unsigned xb_xcc_id() { return (unsigned)__builtin_amdgcn_s_getreg((3 << 11) | 20) & 0xFu; }
#define XB_SPIN(cond, bar) do { unsigned _sp = 0; while (cond) { __builtin_amdgcn_s_sleep(1); \
    if ((++_sp & 255u) == 0u) { if (xb_ld(&(bar)[XB_TMO])) break; if (_sp > XB_SPIN_CAP) { atomicAdd(&(bar)[XB_TMO], 1u); break; } } } } while (0)
__device__ __forceinline__ void xcd_barrier_complete(unsigned* bar, unsigned x, unsigned& nloc, unsigned& nx) {
    const unsigned G = gridDim.x;
    unsigned sum, cnt, mine, sp = 0u;
    for (;;) {
        sum = 0u; cnt = 0u; mine = 0u;
#pragma unroll
        for (unsigned j = 0; j < 16; ++j) { const unsigned c = xb_ld(&bar[XB_XCNT(j)]); sum += c; cnt += (c > 0u) ? 1u : 0u; mine = (j == x) ? c : mine; }
        if (sum == G) break;
        __builtin_amdgcn_s_sleep(1);
        if ((++sp & 255u) == 0u) { if (xb_ld(&bar[XB_TMO])) break; if (sp > XB_SPIN_CAP) { atomicAdd(&bar[XB_TMO], 1u); break; } }
    }
    nloc = mine > 0u ? mine : 1u; nx = cnt > 0u ? cnt : 1u;
}
__device__ __forceinline__ void xcd_barrier(unsigned* bar, volatile LAS unsigned* st) {
    asm volatile("s_waitcnt vmcnt(0)" ::: "memory");
    __syncthreads();
    if (threadIdx.x == 0) {
        const unsigned x = xb_xcc_id();
        __builtin_amdgcn_s_waitcnt(0);
        unsigned nloc = st[0], nx = st[1];
        if (nloc == 0u) { xcd_barrier_complete(bar, x, nloc, nx); st[0] = nloc; st[1] = nx; }
        const unsigned old = xb_add(&bar[XB_XSUB(x)], 1u);
        const unsigned gen = old / nloc;
        if (old + 1u == (gen + 1u) * nloc) {
            __builtin_amdgcn_fence(__ATOMIC_RELEASE, "agent");
            asm volatile("s_waitcnt vmcnt(0)" ::: "memory");
            const unsigned og = xb_add(&bar[XB_TOP], 1u);
            const unsigned tg = og / nx;
            if (og + 1u == (tg + 1u) * nx) xb_add(&bar[XB_TOPGEN], 1u);
            else XB_SPIN(xb_ld(&bar[XB_TOPGEN]) == tg, bar);
            __builtin_amdgcn_fence(__ATOMIC_ACQUIRE, "agent");
            xb_add(&bar[XB_XGEN(x)], 1u);
            asm volatile("s_waitcnt vmcnt(0)" ::: "memory");
        } else {
            XB_SPIN(xb_ld(&bar[XB_XGEN(x)]) == gen, bar);
            __builtin_amdgcn_fence(__ATOMIC_ACQUIRE, "agent");
            asm volatile("s_waitcnt vmcnt(0)" ::: "memory");
        }
    }
    __syncthreads();
}

template <int HW>
__device__ __forceinline__ void pool_item(const bf16_t* __restrict__ PIN, const bf16_t* SPG, bf16_t* A2, const int r0, const int c0) {
    u32x4 rows[8 + 2 * HW], gt[8];
#pragma unroll
    for (int i = 0; i < 8 + 2 * HW; ++i) { const int r = r0 - HW + i; rows[i] = (r >= 0 && r < S) ? *(const u32x4*)(PIN + (size_t)r * D + c0) : (u32x4){0u, 0u, 0u, 0u}; }
#pragma unroll
    for (int i = 0; i < 8; ++i) gt[i] = *(const u32x4*)(SPG + (size_t)(r0 + i) * D + c0);
    f32x4 s0 = (f32x4){0.f, 0.f, 0.f, 0.f}, s1 = s0;
#pragma unroll
    for (int i = 0; i < 2 * HW; ++i) { f32x4 a, b; pg8::unpack8(rows[i], a, b); s0 += a; s1 += b; }
#pragma unroll
    for (int i = 0; i < 8; ++i) { const int s = r0 + i; const int lo_ = s - HW < 0 ? 0 : s - HW, hi_ = s + HW > S ? S : s + HW; const float inv = 1.f / (float)(hi_ - lo_);
        f32x4 a, b, g0, g1; pg8::unpack8(rows[HW + i], a, b); pg8::unpack8(gt[i], g0, g1);
        *(u32x4*)(A2 + (size_t)s * D + c0) = pg8::pack8((s0 * inv - a) * g0, (s1 * inv - b) * g1);
        if (i < 7) { f32x4 na, nb, oa, ob; pg8::unpack8(rows[2 * HW + i], na, nb); pg8::unpack8(rows[i], oa, ob); s0 += na - oa; s1 += nb - ob; } }
}

struct Args { const float* in[17]; float* out; unsigned char* ws; int ph_lo, ph_hi; };

__global__ void __launch_bounds__(NTHREADS, 2) fwd_kernel(Args args) {
    extern __shared__ __attribute__((aligned(16))) unsigned char lds_raw[];
    LAS unsigned char* lds = (LAS unsigned char*)lds_raw;
    cg::grid_group grid = cg::this_grid();
    const int tid = threadIdx.x, lane = tid & 63, wave = __builtin_amdgcn_readfirstlane(tid >> 6);
    const int G = gridDim.x, bid = blockIdx.x;
    const int gw = bid * NWAVES + wave, NGW = G * NWAVES;
    typedef const __attribute__((address_space(4))) unsigned char* kptr_t;
#define KP_DECL kptr_t kp = (kptr_t)__builtin_amdgcn_kernarg_segment_ptr(); asm volatile("" : "+s"(kp)); unsigned char* ws = *(unsigned char* const __attribute__((address_space(4)))*)(kp + 144); (void)ws
#define KIN(i) (*(const float* const __attribute__((address_space(4)))*)(kp + 8 * (i)))
#define KOUT (*(float* const __attribute__((address_space(4)))*)(kp + 136))
    int lo, hi; { kptr_t kp0 = (kptr_t)__builtin_amdgcn_kernarg_segment_ptr(); lo = *(const int __attribute__((address_space(4)))*)(kp0 + 152); hi = *(const int __attribute__((address_space(4)))*)(kp0 + 156); }
#ifndef PHMASK
#define PHMASK 0x7ff
#endif
#define IN(k) (((PHMASK >> (k)) & 1) && lo <= (k) && (k) < hi)
    volatile LAS unsigned* bst = (volatile LAS unsigned*)(lds + LDS_BYTES - 256);
    if (threadIdx.x == 0) { bst[0] = 0u; bst[1] = 0u;
        if (hi - lo > 1) { unsigned* bar0 = (unsigned*)(*(unsigned char* const __attribute__((address_space(4)))*)((kptr_t)__builtin_amdgcn_kernarg_segment_ptr() + 144) + WS_BAR); (void)xb_add(&bar0[XB_XCNT(xb_xcc_id())], 1u); } }
    __syncthreads();
#ifdef TPROBE
#define TS(k) do { if (blockIdx.x == 0 && threadIdx.x == 0) ((volatile LAS unsigned long long*)(lds + LDS_BYTES - 192))[k] = __builtin_amdgcn_s_memrealtime(); } while (0)
#else
#define TS(k) do { } while (0)
#endif
#define SEAM(k) do { if (IN(k) && IN((k) + 1)) { if ((k) == 0 && hi == 0x7fffffff) grid.sync(); else { \
        unsigned* bar_ = (unsigned*)(*(unsigned char* const __attribute__((address_space(4)))*)((kptr_t)__builtin_amdgcn_kernarg_segment_ptr() + 144) + WS_BAR); \
        xcd_barrier(bar_, bst); } } } while (0)

    TS(0);
    if (IN(0)) {
        KP_DECL; const float* cvec = KIN(1); const float* w_ada = KIN(2); const float* w_in = KIN(6); const float* pool_w = KIN(7); const float* w_pp = KIN(14); const float* w_pg = KIN(15); const float* w_out = KIN(16);
        float* adaacc = (float*)(ws + WS_ADA); bf16_t* WIN = (bf16_t*)(ws + WS_WIN); bf16_t* WPP = (bf16_t*)(ws + WS_WPP); bf16_t* WPG = (bf16_t*)(ws + WS_WPG); bf16_t* WOUT = (bf16_t*)(ws + WS_WOUT); bf16_t* POOLW = (bf16_t*)(ws + WS_POOLW);
        for (int it = gw; it < 48 * 64; it += NGW) { const int nc = it % 48, ksl = it / 48; const int n = nc * 64 + lane; float s = 0.f;
#pragma unroll
            for (int kk = 0; kk < 16; ++kk) { const int k = ksl * 16 + kk; const float cv = cvec[k]; s += cv * sigmoidf_(cv) * w_ada[(size_t)k * (3 * D) + n]; }
            atomicAdd(adaacc + n, s); }
        LAS float* scr = (LAS float*)(lds + wave * 16384);
        for (int it = gw; it < 16 + 128; it += NGW) {
            if (it < 16) transpose_item(w_in, D, 7200, WIN, it * 64, 160 * 32, NPROJ, scr, lane);
            else { const int r = it - 16, gI = r / 32, rr = r % 32; const int kb = rr / 8, nb = rr % 8;
                transpose_item(pool_w + (size_t)gI * 65536, 256, 256, POOLW, kb * 64, nb * 32, gI * 256 + nb * 32, scr, lane); } }
        { bf16_t* WINP = (bf16_t*)(ws + WS_WINP);
          for (int i = bid * NTHREADS + tid; i < D * D / 4; i += G * NTHREADS) { const int k = i >> 8, c4 = (i & 255) * 4; const f32x4 v = *(const f32x4*)(w_in + (size_t)k * 7200 + c4);
              *(u32x2*)(WINP + (size_t)k * D + c4) = (u32x2){cvt_pk_bf16(v[0], v[1]), cvt_pk_bf16(v[2], v[3])}; } }
    }
    SEAM(0); TS(1);

    if (IN(1)) {
        KP_DECL; const float* x = KIN(0); const float* b_ada = KIN(3); const float* g_pre = KIN(4); const float* adaacc = (const float*)(ws + WS_ADA); bf16_t* WIN = (bf16_t*)(ws + WS_WIN); float* LR = (float*)(ws + WS_LR); bf16_t* H = (bf16_t*)KOUT;
        {
            const float* pool_scale = KIN(8);
            pg8::Gemm gf{(const bf16_t*)(ws + WS_POOLW), (const bf16_t*)(ws + WS_WINP), D, D, 256, 256, 0, -1, -1, D, 256}; pg8::StaticOrder sof; sof.init(D, D, G, bid);
            pg8::EpiFold Ef{WIN, pool_scale};
            pg8::gemm_phase<pg8::EpiFold>(lds, gf, sof, Ef);
        }
        {
            const float* w_in = KIN(6); const float* pool_w = KIN(7); const float* w_pp = KIN(14); const float* w_pg = KIN(15); const float* w_out = KIN(16);
            bf16_t* WPP = (bf16_t*)(ws + WS_WPP); bf16_t* WPG = (bf16_t*)(ws + WS_WPG); bf16_t* WOUT = (bf16_t*)(ws + WS_WOUT); bf16_t* POOLW = (bf16_t*)(ws + WS_POOLW);
            LAS float* scr = (LAS float*)(lds + wave * 16384);
            constexpr int I_IN = 16 * 225, I_SQ = 16 * 32, I_PW = 4 * 8;
            constexpr int NIT = I_IN + 3 * I_SQ;
            const int nfold = G > 64 ? 16 : 0;
            for (int it = (bid - nfold) * NWAVES + wave; it < NIT && bid >= nfold; it += (G - nfold) * NWAVES) { int r = it;
                if (r < I_IN) { const int kb = r / 225, nb = r % 225; if (nb == 160 || nb < 32) continue; const int drow = nb < 160 ? nb * 32 : (nb - 1) * 32;
                    transpose_item(w_in, D, 7200, WIN, kb * 64, nb * 32, drow, scr, lane); continue; } r -= I_IN;
                if (r < 3 * I_SQ) { const int which = r / I_SQ, rr = r % I_SQ; const int kb = rr / 32, nb = rr % 32;
                    const float* W = which == 0 ? w_pp : (which == 1 ? w_pg : w_out); bf16_t* WT = which == 0 ? WPP : (which == 1 ? WPG : WOUT);
                    transpose_item(W, D, D, WT, kb * 64, nb * 32, nb * 32, scr, lane); continue; } r -= 3 * I_SQ;
            }
            __syncthreads();
        }
        constexpr int HS_PITCH = 2064;
        constexpr int L_HS = 0, L_RED = 16 * HS_PITCH;
        f32x4 gs[4], sh[4];
#pragma unroll
        for (int j = 0; j < 4; ++j) { const int c0 = 4 * lane + 256 * j;
            const f32x4 shv = *(const f32x4*)(adaacc + c0) + *(const f32x4*)(b_ada + c0);
            const f32x4 scv = *(const f32x4*)(adaacc + D + c0) + *(const f32x4*)(b_ada + D + c0);
            gs[j] = *(const f32x4*)(g_pre + c0) * (scv + 1.f); sh[j] = shv; }
        const int fr = lane & 15, fq = lane >> 4;
        bf16x8 bfr[2][4];
#pragma unroll
        for (int nt = 0; nt < 2; ++nt)
#pragma unroll
            for (int kk = 0; kk < 4; ++kk) bfr[nt][kk] = *(const bf16x8*)(WIN + (size_t)(NPROJ + nt * 16 + fr) * D + (4 * wave + kk) * 32 + fq * 8);
        f32x4 xn[2][4];
        if (bid < S / 16) {
#pragma unroll
            for (int rr = 0; rr < 2; ++rr) { const f32x4* xr = (const f32x4*)(x + ((size_t)bid * 16 + 2 * wave + rr) * D) + lane;
#pragma unroll
                for (int j = 0; j < 4; ++j) xn[rr][j] = xr[64 * j]; }
        }
        for (int grp = bid; grp < S / 16; grp += G) {
            f32x4 xc[2][4];
#pragma unroll
            for (int rr = 0; rr < 2; ++rr)
#pragma unroll
                for (int j = 0; j < 4; ++j) xc[rr][j] = xn[rr][j];
            if (grp + G < S / 16) {
#pragma unroll
                for (int rr = 0; rr < 2; ++rr) { const f32x4* xr = (const f32x4*)(x + ((size_t)(grp + G) * 16 + 2 * wave + rr) * D) + lane;
#pragma unroll
                    for (int j = 0; j < 4; ++j) xn[rr][j] = xr[64 * j]; }
            }
#pragma unroll
            for (int rr = 0; rr < 2; ++rr) { const int rl = 2 * wave + rr; const size_t row = (size_t)grp * 16 + rl;
                f32x4 v[4]; float s = 0.f;
#pragma unroll
                for (int j = 0; j < 4; ++j) { v[j] = xc[rr][j]; s += (v[j][0] * v[j][0] + v[j][1] * v[j][1]) + (v[j][2] * v[j][2] + v[j][3] * v[j][3]); }
                const float rstd = __builtin_amdgcn_rsqf(wave_sum(s) * (1.f / D) + RMS_EPS);
#pragma unroll
                for (int j = 0; j < 4; ++j) { const f32x4 hv = v[j] * rstd * gs[j] + sh[j]; const u32x2 pk = (u32x2){cvt_pk_bf16(hv[0], hv[1]), cvt_pk_bf16(hv[2], hv[3])};
                    *(u32x2*)(H + row * D + 4 * lane + 256 * j) = pk; *(LAS u32x2*)(lds + L_HS + rl * HS_PITCH + (4 * lane + 256 * j) * 2) = pk; } }
            LBAR();
            f32x4 pa[2] = {(f32x4){0.f, 0.f, 0.f, 0.f}, (f32x4){0.f, 0.f, 0.f, 0.f}};
#pragma unroll
            for (int kk = 0; kk < 4; ++kk) { const bf16x8 af = *(const LAS bf16x8*)(lds + L_HS + fr * HS_PITCH + ((4 * wave + kk) * 32 + fq * 8) * 2);
                pa[0] = __builtin_amdgcn_mfma_f32_16x16x32_bf16(af, bfr[0][kk], pa[0], 0, 0, 0); pa[1] = __builtin_amdgcn_mfma_f32_16x16x32_bf16(af, bfr[1][kk], pa[1], 0, 0, 0); }
            *(LAS f32x4*)(lds + L_RED + ((wave * 2 + 0) * 64 + lane) * 16) = pa[0]; *(LAS f32x4*)(lds + L_RED + ((wave * 2 + 1) * 64 + lane) * 16) = pa[1];
            LBAR();
            { const int nt = tid >> 8, ll = (tid >> 2) & 63, jj = tid & 3; float s = 0.f;
#pragma unroll
              for (int ww = 0; ww < 8; ++ww) s += *(const LAS float*)(lds + L_RED + ((ww * 2 + nt) * 64 + ll) * 16 + jj * 4);
              LR[((size_t)grp * 16 + (ll >> 4) * 4 + jj) * 32 + nt * 16 + (ll & 15)] = s; }
        }
        __syncthreads();
    }
    SEAM(1); TS(2);

    if (IN(2)) {
        KP_DECL; const bf16_t* H = (const bf16_t*)KOUT; const bf16_t* WIN = (const bf16_t*)(ws + WS_WIN);
        pg8::Gemm g{H, WIN, S, NPROJ, D, D, 0, 12, 16, D, 0}; pg8::StaticOrder so; so.init(S, NPROJ, G, bid, 1);
        pg8::EpiProj E{ws, (bf16_t*)((unsigned char*)KOUT + 32 * MiB)};
        pg8::gemm_phase<pg8::EpiProj>(lds, g, so, E);
    }
    SEAM(2); TS(3);

    TS(4);
    TS(5);

    if (IN(5)) {
        KP_DECL; const float* gk_up_f = KIN(9); const float* gk_bias_f = KIN(10); const float* gk_up_b = KIN(11); const float* gk_bias_b = KIN(12);
        const bf16_t* A2 = (const bf16_t*)KOUT; const bf16_t* KT = (const bf16_t*)((unsigned char*)KOUT + 32 * MiB); const bf16_t* WPP = (const bf16_t*)(ws + WS_WPP); bf16_t* SBP = (bf16_t*)(ws + WS_SBP);
        const bf16_t* Qb = (const bf16_t*)(ws + WS_Q); const bf16_t* Kb = (const bf16_t*)(ws + WS_K); const bf16_t* Vb = (const bf16_t*)(ws + WS_V); const float* LR = (const float*)(ws + WS_LR); float* LTOT = (float*)(ws + WS_LTOT); float* STATES = (float*)KOUT;
        {
        const bf16_t* PIN = (const bf16_t*)(ws + WS_PIN); const bf16_t* SPG = (const bf16_t*)(ws + WS_SPG); bf16_t* A2 = (bf16_t*)(ws + WS_SPG);
        for (int it = bid * NTHREADS + tid; it < (S / 8) * 128; it += G * NTHREADS) { const int cl = it & 31, rbs = (it >> 5) & 1, g = (it >> 6) & 3, rbp = it >> 8;
            const int r0 = (rbp * 2 + rbs) * 8, c0 = (g * 32 + cl) * 8;
            if (g == 0) pool_item<1>(PIN, SPG, A2, r0, c0); else if (g == 1) pool_item<2>(PIN, SPG, A2, r0, c0); else if (g == 2) pool_item<4>(PIN, SPG, A2, r0, c0); else pool_item<8>(PIN, SPG, A2, r0, c0); }
            }
        for (int pr = bid; pr < NSC * NH; pr += G) { f32x4 lr4; u32x4 vt4[4], qg[2], kg[2]; u32x2 ktv[4];
          for (int dir = 0; dir < 2; ++dir) { const int h = pr & 3, sc = pr >> 2;
            int tl = tid; asm volatile("" : "+v"(tl));
            const float* upp = dir ? gk_up_b : gk_up_f; const float* bp = dir ? gk_bias_b : gk_bias_f;
            const int dl = 16 * wave + (tl & 15), fqd = (tl & 63) >> 4;
            bf16x8 ub1, ub2; float bias;
            { unsigned hh[4], ll[4]; float uv[8];
#pragma unroll
              for (int e = 0; e < 8; ++e) uv[e] = upp[((fqd & 1) * 8 + e) * KW + h * HK + dl];
              bias = bp[h * HK + dl];
#pragma unroll
              for (int e2 = 0; e2 < 4; ++e2) { const float v0 = uv[2 * e2], v1 = uv[2 * e2 + 1];
                  hh[e2] = cvt_pk_bf16(v0, v1); ll[e2] = (fqd < 2) ? cvt_pk_bf16(v0 - bflo(hh[e2]), v1 - bfhi(hh[e2])) : 0u; }
              ub1 = __builtin_bit_cast(bf16x8, (u32x4){hh[0], hh[1], hh[2], hh[3]}); ub2 = __builtin_bit_cast(bf16x8, (u32x4){ll[0], ll[1], ll[2], ll[3]}); }
            f32x4 St[8][2];
#pragma unroll
            for (int a = 0; a < 8; ++a) { St[a][0] = (f32x4){0.f, 0.f, 0.f, 0.f}; St[a][1] = (f32x4){0.f, 0.f, 0.f, 0.f}; }
            float ltot = 0.f;
            if (dir == 0) gla_load<false>(tl, (sc * SCN) * CH, h, Qb, Kb, KT, Vb, LR, lr4, vt4, ktv, qg, kg);
            for (int cc = 0; cc < SCN; ++cc) { const int c = dir ? (SCN - 1 - cc) : cc; const int row0 = (sc * SCN + c) * CH;
                const int cn = (cc + 1 < SCN) ? (dir ? c - 1 : c + 1) : c; const int row0n = (sc * SCN + cn) * CH;
                gla_chunk<false>(lds, tl, row0, row0n, h, dir, Qb, Kb, KT, Vb, LR, ub1, ub2, bias, St, ltot, nullptr, nullptr, nullptr, lr4, vt4, ktv, qg, kg); }
            u32x2* sp2 = (u32x2*)((bf16_t*)STATES + ((size_t)(dir * NSC + sc) * NH + h) * (HK * HV)) + wave * 64;
#pragma unroll
            for (int a = 0; a < 8; ++a) { unsigned soa = (unsigned)(a * 1024) + (unsigned)(tl & 63); asm volatile("" : "+v"(soa));
                sp2[soa] = (u32x2){cvt_pk_bf16(St[a][0][0], St[a][0][1]), cvt_pk_bf16(St[a][0][2], St[a][0][3])};
                sp2[soa + 512] = (u32x2){cvt_pk_bf16(St[a][1][0], St[a][1][1]), cvt_pk_bf16(St[a][1][2], St[a][1][3])};
                __builtin_amdgcn_sched_barrier(0); }
            if (fqd == 0) LTOT[((size_t)(dir * NSC + sc) * NH + h) * HK + dl] = ltot;
        } }
    }
    SEAM(5); TS(6);

    if (IN(6)) {
        KP_DECL; const float* LTOT = (const float*)(ws + WS_LTOT); float* STATES = (float*)KOUT;
        typedef float f32x2 __attribute__((ext_vector_type(2)));
        for (int base = bid * NTHREADS; base < 2 * NH * 8192 * 2; base += G * NTHREADS) { const int e2 = base + tid, e = e2 >> 1, hp = e2 & 1; const int dir = e >> 15, h = (e >> 13) & 3, slot = e & 8191;
            const int a16 = (slot >> 10) * 16, dkl = ((slot >> 4) & 3) * 4 + hp * 2;
            __syncthreads();
            for (int i = tid; i < NSC * 16; i += NTHREADS) { const int sc = i >> 4, c = i & 15; ((LAS float*)lds)[i] = __expf(LTOT[((size_t)(dir * NSC + sc) * NH + h) * HK + a16 + c]); }
            __syncthreads();
            f32x2 carry = (f32x2){0.f, 0.f};
            unsigned* sb = (unsigned*)STATES + (size_t)slot * 2 + hp;
            for (int i0 = 0; i0 < NSC; i0 += 16) { unsigned t[16];
#pragma unroll
                for (int u = 0; u < 16; ++u) { const int sc = dir ? (NSC - 1 - (i0 + u)) : (i0 + u); t[u] = sb[((size_t)(dir * NSC + sc) * NH + h) * (HK * HV / 2)]; }
#pragma unroll
                for (int u = 0; u < 16; ++u) { const int sc = dir ? (NSC - 1 - (i0 + u)) : (i0 + u); const f32x2 dcy = *(const LAS f32x2*)(lds + (sc * 16 + dkl) * 4);
                    sb[((size_t)(dir * NSC + sc) * NH + h) * (HK * HV / 2)] = cvt_pk_bf16(carry[0], carry[1]);
                    carry[0] = dcy[0] * carry[0] + bflo(t[u]); carry[1] = dcy[1] * carry[1] + bfhi(t[u]); } }
        }
    }
    SEAM(6); TS(7);

    if (IN(7)) {
        KP_DECL; const float* gk_up_f = KIN(9); const float* gk_bias_f = KIN(10); const float* gk_up_b = KIN(11); const float* gk_bias_b = KIN(12); const float* gla_norm_g = KIN(13);
        const bf16_t* Qb = (const bf16_t*)(ws + WS_Q); const bf16_t* Kb = (const bf16_t*)(ws + WS_K); const bf16_t* Vb = (const bf16_t*)(ws + WS_V); const float* LR = (const float*)(ws + WS_LR); const float* STATES = (const float*)KOUT;
        bf16_t* SGG = (bf16_t*)(ws + WS_SGG); bf16_t* OFb = (bf16_t*)(ws + WS_PIN); const bf16_t* KT = (const bf16_t*)((unsigned char*)KOUT + 32 * MiB);
        for (int item = bid; item < NSC * NH; item += G) { const int h = item & 3, sc = item >> 2;
            int tl = tid; asm volatile("" : "+v"(tl));
            const int d = tl & 127, fr = tl & 15, fq = (tl & 63) >> 4;
            f32x4 lr4; u32x4 vt4[4], qg[2], kg[2]; u32x2 ktv[4];
            __syncthreads(); if (tl < 64) ((LAS f32x4*)(lds + L_GN))[tl] = ((const f32x4*)gla_norm_g)[tl];
            for (int dir = 0; dir < 2; ++dir) {
                const float* upp = dir ? gk_up_b : gk_up_f; const float* bp = dir ? gk_bias_b : gk_bias_f;
                const int dl = 16 * wave + fr;
                bf16x8 ub1, ub2; float bias;
                { unsigned hh[4], ll[4]; float uv[8];
#pragma unroll
                  for (int e = 0; e < 8; ++e) uv[e] = upp[((fq & 1) * 8 + e) * KW + h * HK + dl];
                  bias = bp[h * HK + dl];
#pragma unroll
                  for (int e2 = 0; e2 < 4; ++e2) { const float v0 = uv[2 * e2], v1 = uv[2 * e2 + 1];
                      hh[e2] = cvt_pk_bf16(v0, v1); ll[e2] = (fq < 2) ? cvt_pk_bf16(v0 - bflo(hh[e2]), v1 - bfhi(hh[e2])) : 0u; }
                  ub1 = __builtin_bit_cast(bf16x8, (u32x4){hh[0], hh[1], hh[2], hh[3]}); ub2 = __builtin_bit_cast(bf16x8, (u32x4){ll[0], ll[1], ll[2], ll[3]}); }
                const u32x2* sp2 = (const u32x2*)((const bf16_t*)STATES + ((size_t)(dir * NSC + sc) * NH + h) * (HK * HV)) + wave * 64;
                if (dir == 0) gla_load<true>(tl, (sc * SCN) * CH, h, Qb, Kb, KT, Vb, LR, lr4, vt4, ktv, qg, kg);
                f32x4 St[8][2];
                { u32x2 raw[8][2];
#pragma unroll
                  for (int a = 0; a < 8; ++a) { unsigned soa = (unsigned)(a * 1024) + (unsigned)(tl & 63); asm volatile("" : "+v"(soa)); raw[a][0] = sp2[soa]; raw[a][1] = sp2[soa + 512]; }
#pragma unroll
                  for (int a = 0; a < 8; ++a) { const u32x2 p0 = raw[a][0], p1 = raw[a][1];
                    St[a][0] = (f32x4){bflo(p0.x), bfhi(p0.x), bflo(p0.y), bfhi(p0.y)}; St[a][1] = (f32x4){bflo(p1.x), bfhi(p1.x), bflo(p1.y), bfhi(p1.y)}; } }
                float ltot = 0.f;
                for (int cc = 0; cc < SCN; ++cc) { const int c = dir ? (SCN - 1 - cc) : cc; const int row0 = (sc * SCN + c) * CH;
                    const int cn = (cc + 1 < SCN) ? (dir ? c - 1 : c + 1) : c; const int row0n = (sc * SCN + cn) * CH;
                    gla_chunk<true>(lds, tl, row0, row0n, h, dir, Qb, Kb, KT, Vb, LR, ub1, ub2, bias, St, ltot, OFb, SGG, gla_norm_g, lr4, vt4, ktv, qg, kg); }
            }
        }
    }
    SEAM(7); TS(8);

    if (IN(8)) {
        KP_DECL; const bf16_t* SGG = (const bf16_t*)(ws + WS_SGG); const bf16_t* WPG = (const bf16_t*)(ws + WS_WPG); const bf16_t* SBP = (const bf16_t*)(ws + WS_SBP); bf16_t* SBG = (bf16_t*)(ws + WS_SBG);
        const bf16_t* A2 = (const bf16_t*)(ws + WS_SPG); const bf16_t* WPP = (const bf16_t*)(ws + WS_WPP);
        pg8::Gemm g{A2, WPP, S, D, D, D, 0, -1, -1, D, 0}; pg8::StaticOrder so; so.init(S, D, G, bid, 0, 1);
        pg8::EpiDual E{pg8::EpiYPool{(bf16_t*)SBP}, pg8::EpiYGla{SBP, SBG}};
        pg8::gemm_phase<pg8::EpiDual>(lds, g, so, E);
    }
    SEAM(8); TS(9);

    if (IN(9)) {
        KP_DECL; const bf16_t* SBG = (const bf16_t*)(ws + WS_SBG); const bf16_t* WOUT = (const bf16_t*)(ws + WS_WOUT); float* OUT = KOUT; float* rowsq = (float*)(ws + WS_ROWSQ);
        const float* x = KIN(0); const float* b_ada = KIN(3); const float* g_post = KIN(5); const float* adaacc = (const float*)(ws + WS_ADA);
        pg8::Gemm g{SBG, WOUT, S, D, D, D, 0, -1, -1, D, 0}; pg8::StaticOrder so; so.init(S, D, G, bid);
        if (G == (S / 256) * (D / 256)) {
            pg8::EpiOutFused E{x, OUT, rowsq, (unsigned*)(ws + WS_PCNT), adaacc, b_ada, g_post};
            pg8::gemm_phase<pg8::EpiOutFused>(lds, g, so, E);
        }
#ifdef TPROBE
        __syncthreads();
        if (blockIdx.x == 0 && threadIdx.x == 0) { asm volatile("s_waitcnt vmcnt(0)" ::: "memory"); volatile LAS unsigned long long* tsb = (volatile LAS unsigned long long*)(lds + LDS_BYTES - 192);
            float acc_us = 0.f; const unsigned msk = TPROBE;
            for (int k = 0; k < 9; ++k) if ((msk >> k) & 1u) acc_us += (float)(tsb[k + 1] - tsb[k]) * 0.01f;
            if ((msk >> 9) & 1u) acc_us += (float)(__builtin_amdgcn_s_memrealtime() - tsb[9]) * 0.01f;
            OUT[0] += acc_us * TPSCALE; }
#endif
    }
#undef IN
#undef SEAM
}

constexpr int NPHASES = 10;
extern "C" void kernel_launch(void* const* d_in, const int* in_sizes, int n_in, void* d_out, int out_size, void* d_ws, size_t ws_size, hipStream_t stream) {
    static int grid = 0;
    if (grid == 0) {
        if (n_in != 17 || out_size != S * D || ws_size < WS_END) { fprintf(stderr, "kernel_launch: unexpected problem shape (n_in %d out %d ws %zu)\n", n_in, out_size, ws_size); grid = -1; return; }
        int dev = 0, cus = 0, per_cu = 0;
        hipGetDevice(&dev); hipDeviceGetAttribute(&cus, hipDeviceAttributeMultiprocessorCount, dev);
        if (hipFuncSetAttribute((const void*)fwd_kernel, hipFuncAttributeMaxDynamicSharedMemorySize, LDS_BYTES) != hipSuccess) { fprintf(stderr, "kernel_launch: hipFuncSetAttribute failed\n"); grid = -1; return; }
        if (hipOccupancyMaxActiveBlocksPerMultiprocessor(&per_cu, (const void*)fwd_kernel, NTHREADS, LDS_BYTES) != hipSuccess || per_cu < 1) { fprintf(stderr, "kernel_launch: occupancy query says %d\n", per_cu); per_cu = 1; (void)hipGetLastError(); }
        grid = cus * 1;
        if (grid > cus * per_cu) grid = cus * per_cu;
    }
    if (grid < 0) return;
    hipMemsetAsync((char*)d_ws + WS_CTL, 0, CTL_ZERO_BYTES, stream);
    Args a{};
    for (int i = 0; i < 17; ++i) a.in[i] = (const float*)d_in[i];
    a.out = (float*)d_out; a.ws = (unsigned char*)d_ws;
#if ONE_LAUNCH
    a.ph_lo = 0; a.ph_hi = NPHASES;
    void* kargs[] = {&a};
    hipError_t e = hipLaunchCooperativeKernel((const void*)fwd_kernel, dim3(grid), dim3(NTHREADS), kargs, LDS_BYTES, stream);
    if (e != hipSuccess) fprintf(stderr, "cooperative launch failed: %s (grid %d)\n", hipGetErrorString(e), grid);
#else
    for (int p = 0; p < NPHASES; ++p) { a.ph_lo = p; a.ph_hi = p + 1;
        hipLaunchKernelGGL(fwd_kernel, dim3(grid), dim3(NTHREADS), LDS_BYTES, stream, a); }
#endif
}
```

```cpp
#include <hip/hip_runtime.h>
#include <hip/hip_cooperative_groups.h>
#include <cstdio>
#include <cstdint>
namespace cg = cooperative_groups;

#ifndef ONE_LAUNCH
#define ONE_LAUNCH 1
#endif

#define LAS __attribute__((address_space(3)))
typedef unsigned short bf16_t;
typedef short bf16x8 __attribute__((ext_vector_type(8)));
typedef float f32x4 __attribute__((ext_vector_type(4)));
typedef unsigned u32x4 __attribute__((ext_vector_type(4)));
typedef unsigned u32x2 __attribute__((ext_vector_type(2)));

constexpr int S = 16384, D = 1024, NPROJ = 7168, KW = 512, HK = 128, HV = 256, NH = 4, RANK = 16;
constexpr int CH = 64, SCN = 4, NSC = S / (CH * SCN);
constexpr float RMS_EPS = 1e-6f;
constexpr int NTHREADS = 512, NWAVES = 8;
constexpr int LDS_BYTES = 163840;

constexpr size_t MiB = 1u << 20;
constexpr size_t WS_CTL = 0, CTL_ZERO_BYTES = 128 * 1024;
constexpr size_t WS_ADA = 0, WS_ROWSQ = 16 * 1024, WS_BAR = 96 * 1024, WS_PCNT = 112 * 1024;
constexpr size_t WS_WIN = 1 * MiB;
constexpr size_t WS_WPP = 16 * MiB, WS_WPG = 18 * MiB, WS_WOUT = 20 * MiB, WS_POOLW = 22 * MiB;
constexpr size_t WS_LR = 23 * MiB;
constexpr size_t WS_LTOT = 25 * MiB;
constexpr size_t WS_PIN = 26 * MiB, WS_SPG = 58 * MiB, WS_Q = 90 * MiB, WS_K = 106 * MiB, WS_V = 122 * MiB, WS_SGG = 154 * MiB, WS_SBP = 186 * MiB, WS_SBG = 218 * MiB;
constexpr size_t WS_STATES = 26 * MiB;
constexpr size_t WS_WINP = 250 * MiB;
constexpr size_t WS_END = 252 * MiB;

__device__ __forceinline__ unsigned cvt_pk_bf16(float lo, float hi) { unsigned r; asm volatile("v_cvt_pk_bf16_f32 %0, %1, %2" : "=v"(r) : "v"(lo), "v"(hi)); return r; }
__device__ __forceinline__ float bflo(unsigned u) { return __builtin_bit_cast(float, u << 16); }
__device__ __forceinline__ float bfhi(unsigned u) { return __builtin_bit_cast(float, u & 0xffff0000u); }
__device__ __forceinline__ float bf1(bf16_t u) { return __builtin_bit_cast(float, (unsigned)u << 16); }
__device__ __forceinline__ float sigmoidf_(float x) { return __builtin_amdgcn_rcpf(1.f + __expf(-x)); }
template <int CTRL> __device__ __forceinline__ float dppx(float x) { return __builtin_bit_cast(float, __builtin_amdgcn_update_dpp(0, __builtin_bit_cast(int, x), CTRL, 0xF, 0xF, false)); }
__device__ __forceinline__ float wave_sum(float v) {
#pragma unroll
    for (int o = 1; o < 64; o <<= 1) v += __shfl_xor(v, o);
    return v;
}

namespace pg8 {
constexpr int BM = 256, BK = 64, HALF = 128, HTB = HALF * BK * 2, NXCD = 8, WGM = 8;
__host__ __device__ __forceinline__ int lds_byte(int r, int c) { const int st = (r >> 4) * 2 + (c >> 5), rr = r & 15, cc = c & 31, ob = rr * 64 + cc * 2; return st * 1024 + (ob ^ (((ob >> 9) & 1) << 5)); }
__host__ __device__ __forceinline__ void stage_rc(int b, int& R, int& C) { const int st = b / 1024, sb = b % 1024, swz = sb ^ (((sb >> 9) & 1) << 5); R = (st >> 1) * 16 + swz / 64; C = (st & 1) * 32 + (swz % 64) / 2; }
__host__ __device__ __forceinline__ int perm32(int rho) { const int n = rho >> 4, i = rho & 15; return 8 * (i >> 2) + 4 * n + (i & 3); }

struct Unit { int pm, pn, w; };
struct Gemm { const bf16_t* A; const bf16_t* Bt; int M, N, K, lda, a_pn_off, tr_lo, tr_hi, ldb, b_pm_off; };

struct StaticOrder {
    int nM, nN, nwg, G, c, rev, dual;
    __device__ void init(int M, int N, int G_, int c_, int rev_ = 0, int dual_ = 0) { nM = M / BM; nN = N / BM; nwg = nM * nN; G = G_; c = c_; rev = rev_; dual = dual_; }
    __device__ bool next(int i_, Unit& u) const {
        const int i = dual ? (i_ >> 1) : i_; u.w = dual ? (i_ & 1) : 0;
        const long L = (long)i * G + c; if (L >= nwg) return false;
        int wgid = (int)L; { const int q = nwg / NXCD, r = nwg % NXCD, xcd = wgid % NXCD, off = wgid / NXCD; wgid = (xcd < r ? xcd * (q + 1) : r * (q + 1) + (xcd - r) * q) + off; }
        const int nig = WGM * nN, gid = wgid / nig, fm = gid * WGM, gsz = (nM - fm) < WGM ? (nM - fm) : WGM;
        u.pm = fm + ((wgid % nig) % gsz); u.pn = (wgid % nig) / gsz; if (rev) u.pn = nN - 1 - u.pn; return true;
    }
};

template <class Epi>
__device__ __forceinline__ void gemm_phase(LAS unsigned char* lds, const Gemm g, const StaticOrder& S, const Epi& E) {
    const int tid = threadIdx.x, wid = __builtin_amdgcn_readfirstlane(tid >> 6), lane = tid & 63, wr = wid >> 2, wc = wid & 3, fr = lane & 15, fq = lane >> 4;
    const int K = g.K, nt = K / BK, lda = g.lda, ldb = g.ldb;
    unsigned voffA[2], voffB[2];
#pragma unroll
    for (int i = 0; i < 2; ++i) { int R, C; stage_rc(tid * 16 + i * 8192, R, C); const int Rb = (R & ~31) + perm32(R & 31);
        voffA[i] = (unsigned)(R * lda + C) * 2u; voffB[i] = (unsigned)(Rb * ldb + C) * 2u; }
    const size_t kstep = (size_t)(BK * 2);
    const size_t hstepA = (size_t)HALF * lda * 2, hstepB = (size_t)HALF * ldb * 2;
    const size_t tstepA = 2 * hstepA, tstepB = 2 * hstepB;
    const unsigned ldsw = (unsigned)wid * 1024u;
    const int aoff = lds_byte(wr * 64 + fr, fq * 8), boff = lds_byte(wc * 32 + fr, fq * 8);
#define PG8_SA(b, h) (((b) * 2 + (h)) * HTB)
#define PG8_SB(b, h) ((4 + (b) * 2 + (h)) * HTB)
#define PG8_STAGE(bufoff, gbase, voff) do { _Pragma("unroll") for (int _i = 0; _i < 2; ++_i) \
        __builtin_amdgcn_global_load_lds((const unsigned*)((const char*)(gbase) + (voff)[_i]), (LAS unsigned*)(lds + (bufoff) + ldsw + _i * 8192), 16, 0, 0); } while (0)
#define PG8_LDA(dst, b, h) do { _Pragma("unroll") for (int m = 0; m < 4; ++m) _Pragma("unroll") for (int k = 0; k < 2; ++k) dst[m][k] = *(const LAS bf16x8*)(lds + PG8_SA(b, h) + aoff + m * 2048 + k * 1024); } while (0)
#define PG8_LDB(dst, b, h) do { _Pragma("unroll") for (int n = 0; n < 2; ++n) _Pragma("unroll") for (int k = 0; k < 2; ++k) dst[n][k] = *(const LAS bf16x8*)(lds + PG8_SB(b, h) + boff + n * 2048 + k * 1024); } while (0)
#define PG8_MMA(ai, bj, At, Bt) do { __builtin_amdgcn_s_setprio(1); _Pragma("unroll") for (int m = 0; m < 4; ++m) _Pragma("unroll") for (int n = 0; n < 2; ++n) _Pragma("unroll") for (int k = 0; k < 2; ++k) \
        acc[ai][bj][m][n] = __builtin_amdgcn_mfma_f32_16x16x32_bf16(Bt[n][k], At[m][k], acc[ai][bj][m][n], 0, 0, 0); __builtin_amdgcn_s_setprio(0); } while (0)
#define PG8_WAIT_V(n) asm volatile("s_waitcnt vmcnt(" #n ")" ::: "memory")
#define PG8_WAIT_L(n) asm volatile("s_waitcnt lgkmcnt(" #n ")" ::: "memory")
#define PG8_BAR __builtin_amdgcn_s_barrier()
#define PG8_SCHED __builtin_amdgcn_sched_barrier(0)
    Unit cur, nxt; int ui = 0;
    if (!S.next(0, cur)) return;
    f32x4 acc[2][2][4][2];
#pragma unroll
    for (int a = 0; a < 2; ++a)
#pragma unroll
        for (int b = 0; b < 2; ++b)
#pragma unroll
            for (int m = 0; m < 4; ++m)
#pragma unroll
                for (int n = 0; n < 2; ++n) acc[a][b][m][n] = (f32x4){0.f, 0.f, 0.f, 0.f};
    bf16x8 At[4][2], B0[2][2], B1[2][2];
#define PG8_UPTR(u, pa, pb) do { if ((u).pn >= g.tr_lo && (u).pn < g.tr_hi) { pa = (const char*)g.Bt + (size_t)(u).pn * tstepB; pb = (const char*)g.A + (size_t)(u).pm * tstepA; } \
        else if ((u).w) { const char* ws_ = *(const char* const __attribute__((address_space(4)))*)((const __attribute__((address_space(4))) unsigned char*)__builtin_amdgcn_kernarg_segment_ptr() + 144);     \
            pa = ws_ + WS_SGG + (size_t)(u).pm * tstepA; pb = ws_ + WS_WPG + (size_t)(u).pn * tstepB; } \
        else { pa = (const char*)g.A + (size_t)(u).pm * tstepA + (size_t)(u).pn * g.a_pn_off * 2; pb = (const char*)g.Bt + (size_t)(u).pn * tstepB + (size_t)(u).pm * g.b_pm_off * 2; } } while (0)
    const char* cA; const char* cB; PG8_UPTR(cur, cA, cB);
    PG8_STAGE(PG8_SB(0, 0), cB, voffB); PG8_STAGE(PG8_SB(0, 1), cB + hstepB, voffB); PG8_STAGE(PG8_SA(0, 0), cA, voffA); PG8_STAGE(PG8_SA(0, 1), cA + hstepA, voffA);
    if (wr == 1) PG8_BAR;
    PG8_WAIT_V(2); PG8_BAR;
    PG8_STAGE(PG8_SB(1, 0), cB + kstep, voffB); PG8_STAGE(PG8_SA(1, 0), cA + kstep, voffA); PG8_STAGE(PG8_SB(1, 1), cB + hstepB + kstep, voffB);
    PG8_WAIT_V(6); PG8_BAR;
    for (;;) {
        const bool has_next = S.next(ui + 1, nxt);
        const char* nA = cA; const char* nB = cB; if (has_next) PG8_UPTR(nxt, nA, nB);
        for (int t = 0; t < nt; t += 2) {
            const bool last = (t == nt - 2);
            const char* a1 = cA + (size_t)(t + 1) * kstep;
            const char* a2 = last ? nA : cA + (size_t)(t + 2) * kstep; const char* b2 = last ? nB : cB + (size_t)(t + 2) * kstep;
            const char* a3 = a2 + kstep; const char* b3 = b2 + kstep;
            PG8_LDB(B0, 0, 0); PG8_LDB(B1, 0, 1); PG8_SCHED; PG8_LDA(At, 0, 0); PG8_STAGE(PG8_SA(1, 1), a1 + hstepA, voffA);
            PG8_WAIT_V(8); PG8_WAIT_L(0); PG8_BAR; PG8_MMA(0, 0, At, B0); PG8_MMA(0, 1, At, B1); PG8_BAR; PG8_SCHED;
            PG8_LDA(At, 0, 1); PG8_STAGE(PG8_SB(0, 0), b2, voffB); PG8_STAGE(PG8_SB(0, 1), b2 + hstepB, voffB); PG8_STAGE(PG8_SA(0, 0), a2, voffA);
            PG8_WAIT_V(8); PG8_WAIT_L(0); PG8_BAR; PG8_MMA(1, 0, At, B0); PG8_MMA(1, 1, At, B1); PG8_BAR; PG8_SCHED;
            PG8_LDB(B0, 1, 0); PG8_LDB(B1, 1, 1); PG8_SCHED; PG8_LDA(At, 1, 0); PG8_STAGE(PG8_SA(0, 1), a2 + hstepA, voffA);
            PG8_WAIT_V(8); PG8_WAIT_L(0); PG8_BAR; PG8_MMA(0, 0, At, B0); PG8_MMA(0, 1, At, B1); PG8_BAR; PG8_SCHED;
            PG8_LDA(At, 1, 1); PG8_STAGE(PG8_SB(1, 0), b3, voffB); PG8_STAGE(PG8_SB(1, 1), b3 + hstepB, voffB); PG8_STAGE(PG8_SA(1, 0), a3, voffA);
            PG8_WAIT_V(8); PG8_WAIT_L(0); PG8_BAR; PG8_MMA(1, 0, At, B0); PG8_MMA(1, 1, At, B1); PG8_BAR; PG8_SCHED;
        }
        if (wr == 0) PG8_BAR;
        E(acc, cur, wr, wc, fr, fq);
        if (!has_next) break;
#pragma unroll
        for (int a = 0; a < 2; ++a)
#pragma unroll
            for (int b = 0; b < 2; ++b)
#pragma unroll
                for (int m = 0; m < 4; ++m)
#pragma unroll
                    for (int n = 0; n < 2; ++n) acc[a][b][m][n] = (f32x4){0.f, 0.f, 0.f, 0.f};
        cur = nxt; cA = nA; cB = nB; ++ui;
        if (wr == 1) PG8_BAR;
    }
    PG8_WAIT_V(0);
    PG8_BAR;
#undef PG8_UPTR
#undef PG8_SA
#undef PG8_SB
#undef PG8_STAGE
#undef PG8_LDA
#undef PG8_LDB
#undef PG8_MMA
#undef PG8_WAIT_V
#undef PG8_WAIT_L
#undef PG8_BAR
#undef PG8_SCHED
}

__device__ __forceinline__ u32x4 pack8(f32x4 v0, f32x4 v1) { u32x4 w; w.x = cvt_pk_bf16(v0[0], v0[1]); w.y = cvt_pk_bf16(v0[2], v0[3]); w.z = cvt_pk_bf16(v1[0], v1[1]); w.w = cvt_pk_bf16(v1[2], v1[3]); return w; }
__device__ __forceinline__ void unpack8(u32x4 w, f32x4& v0, f32x4& v1) { v0 = (f32x4){bflo(w.x), bfhi(w.x), bflo(w.y), bfhi(w.y)}; v1 = (f32x4){bflo(w.z), bfhi(w.z), bflo(w.w), bfhi(w.w)}; }

struct EpiProj {
    unsigned char* ws; bf16_t* kt;
    __device__ __forceinline__ void operator()(const f32x4 (&acc)[2][2][4][2], const Unit& u, int wr, int wc, int fr, int fq) const {
        const int t = u.pn;
        if (t >= 12 && t < 16) {
            bf16_t* vt = (bf16_t*)(ws + WS_V);
            const int vrow0 = (t - 12) * 256 + wr * 64 + fr, tok0 = u.pm * BM + wc * 32 + 8 * fq;
#pragma unroll
            for (int ai = 0; ai < 2; ++ai)
#pragma unroll
                for (int m = 0; m < 4; ++m) { const int vrow = vrow0 + ai * HALF + m * 16;
#pragma unroll
                    for (int bj = 0; bj < 2; ++bj) { const int tok = tok0 + bj * HALF;
                        *(u32x4*)(vt + ((size_t)(tok >> 6) * 1024 + vrow) * 64 + (tok & 63)) = pack8(acc[ai][bj][m][0], acc[ai][bj][m][1]); } }
            return;
        }
        size_t off; int pitch, colt, act; float sc = 1.f;
        if (t < 4)       { off = WS_PIN; pitch = D;  colt = t * 256;        act = 0; }
        else if (t < 8)  { off = WS_SPG; pitch = D;  colt = (t - 4) * 256;  act = 1; }
        else if (t < 10) { off = WS_Q;   pitch = KW; colt = (t - 8) * 256;  act = 0; sc = 0.08838834764831845f; }
        else if (t < 12) { off = WS_K;   pitch = KW; colt = (t - 10) * 256; act = 0; }
        else if (t < 20) { off = WS_SGG; pitch = D;  colt = (t - 16) * 256; act = 1; }
        else if (t < 24) { off = WS_SBP; pitch = D;  colt = (t - 20) * 256; act = 2; }
        else             { off = WS_SBG; pitch = D;  colt = (t - 24) * 256; act = 2; }
        bf16_t* base = (bf16_t*)(ws + off);
        const int row0 = u.pm * BM + wr * 64 + fr, col0 = colt + wc * 32 + 8 * fq;
#pragma unroll
        for (int ai = 0; ai < 2; ++ai)
#pragma unroll
            for (int m = 0; m < 4; ++m) { bf16_t* rowp = base + (size_t)(row0 + ai * HALF + m * 16) * pitch + col0;
#pragma unroll
                for (int bj = 0; bj < 2; ++bj) { f32x4 v0 = acc[ai][bj][m][0], v1 = acc[ai][bj][m][1];
                    if (act == 1) {
#pragma unroll
                        for (int e = 0; e < 4; ++e) { v0[e] = v0[e] * sigmoidf_(v0[e]); v1[e] = v1[e] * sigmoidf_(v1[e]); }
                    } else if (act == 2) {
#pragma unroll
                        for (int e = 0; e < 4; ++e) { v0[e] = sigmoidf_(v0[e]); v1[e] = sigmoidf_(v1[e]); }
                    } else if (sc != 1.f) { v0 = v0 * sc; v1 = v1 * sc; }
                    *(u32x4*)(rowp + bj * HALF) = pack8(v0, v1); } }
        if (t >= 10 && t < 12) {
#pragma unroll
            for (int ai = 0; ai < 2; ++ai)
#pragma unroll
                for (int m = 0; m < 4; ++m) { const int row = row0 + ai * HALF + m * 16; bf16_t* cp = kt + ((size_t)(row >> 6) * 512 + col0) * 64 + (row & 63);
#pragma unroll
                    for (int bj = 0; bj < 2; ++bj) { const u32x4 pk = pack8(acc[ai][bj][m][0], acc[ai][bj][m][1]); bf16_t* cq = cp + (bj * HALF) * 64;
                        cq[0] = (bf16_t)(pk.x & 0xffffu); cq[1 * 64] = (bf16_t)(pk.x >> 16); cq[2 * 64] = (bf16_t)(pk.y & 0xffffu); cq[3 * 64] = (bf16_t)(pk.y >> 16);
                        cq[4 * 64] = (bf16_t)(pk.z & 0xffffu); cq[5 * 64] = (bf16_t)(pk.z >> 16); cq[6 * 64] = (bf16_t)(pk.w & 0xffffu); cq[7 * 64] = (bf16_t)(pk.w >> 16); } }
        }
    }
};
struct EpiFold {
    bf16_t* win; const float* pscale;
    __device__ __forceinline__ void operator()(const f32x4 (&acc)[2][2][4][2], const Unit& u, int wr, int wc, int fr, int fq) const {
        const int row0 = u.pm * BM + wr * 64 + fr, col0 = u.pn * BM + wc * 32 + 8 * fq;
        float psv[2][4];
#pragma unroll
        for (int ai = 0; ai < 2; ++ai)
#pragma unroll
            for (int m = 0; m < 4; ++m) psv[ai][m] = pscale[row0 + ai * HALF + m * 16];
#pragma unroll
        for (int ai = 0; ai < 2; ++ai)
#pragma unroll
            for (int m = 0; m < 4; ++m) { const int row = row0 + ai * HALF + m * 16; const float ps = psv[ai][m];
#pragma unroll
                for (int bj = 0; bj < 2; ++bj) *(u32x4*)(win + (size_t)row * D + col0 + bj * HALF) = pack8(acc[ai][bj][m][0] * ps, acc[ai][bj][m][1] * ps); }
    }
};
struct EpiYPool {
    bf16_t* sbp;
    __device__ __forceinline__ void operator()(const f32x4 (&acc)[2][2][4][2], const Unit& u, int wr, int wc, int fr, int fq) const {
        const int row0 = u.pm * BM + wr * 64 + fr, col0 = u.pn * BM + wc * 32 + 8 * fq;
#pragma unroll
        for (int ai = 0; ai < 2; ++ai) { u32x4 gv[4][2];
#pragma unroll
            for (int m = 0; m < 4; ++m)
#pragma unroll
                for (int bj = 0; bj < 2; ++bj) gv[m][bj] = *(const u32x4*)(sbp + (size_t)(row0 + ai * HALF + m * 16) * D + col0 + bj * HALF);
#pragma unroll
            for (int m = 0; m < 4; ++m)
#pragma unroll
                for (int bj = 0; bj < 2; ++bj) { f32x4 g0, g1; unpack8(gv[m][bj], g0, g1);
                    *(u32x4*)(sbp + (size_t)(row0 + ai * HALF + m * 16) * D + col0 + bj * HALF) = pack8(acc[ai][bj][m][0] * g0, acc[ai][bj][m][1] * g1); } }
    }
};
struct EpiYGla {
    const bf16_t* sbp; bf16_t* sbg;
    __device__ __forceinline__ void operator()(const f32x4 (&acc)[2][2][4][2], const Unit& u, int wr, int wc, int fr, int fq) const {
        const int row0 = u.pm * BM + wr * 64 + fr, col0 = u.pn * BM + wc * 32 + 8 * fq;
#pragma unroll
        for (int ai = 0; ai < 2; ++ai) { u32x4 gv[4][2], pv[4][2];
#pragma unroll
            for (int m = 0; m < 4; ++m)
#pragma unroll
                for (int bj = 0; bj < 2; ++bj) { const size_t ro = (size_t)(row0 + ai * HALF + m * 16) * D + col0 + bj * HALF; gv[m][bj] = *(const u32x4*)(sbg + ro); pv[m][bj] = *(const u32x4*)(sbp + ro); }
#pragma unroll
            for (int m = 0; m < 4; ++m)
#pragma unroll
                for (int bj = 0; bj < 2; ++bj) { const size_t ro = (size_t)(row0 + ai * HALF + m * 16) * D + col0 + bj * HALF; f32x4 g0, g1, p0, p1; unpack8(gv[m][bj], g0, g1); unpack8(pv[m][bj], p0, p1);
                    *(u32x4*)(sbg + ro) = pack8(p0 + acc[ai][bj][m][0] * g0, p1 + acc[ai][bj][m][1] * g1); } }
    }
};
struct EpiDual {
    EpiYPool e0; EpiYGla e1;
    __device__ __forceinline__ void operator()(const f32x4 (&acc)[2][2][4][2], const Unit& u, int wr, int wc, int fr, int fq) const {
        if (u.w == 0) e0(acc, u, wr, wc, fr, fq); else e1(acc, u, wr, wc, fr, fq);
    }
};
struct EpiOutFused {
    const float* x; float* y; float* rowsq; unsigned* pcnt; const float* adaacc; const float* b_ada; const float* g_post;
    __device__ __forceinline__ void operator()(const f32x4 (&acc)[2][2][4][2], const Unit& u, int wr, int wc, int fr, int fq) const {
        const int row0 = u.pm * BM + wr * 64 + fr, col0 = u.pn * BM + wc * 32 + 8 * fq;
#pragma unroll
        for (int ai = 0; ai < 2; ++ai)
#pragma unroll
            for (int m = 0; m < 4; ++m) { const int row = row0 + ai * HALF + m * 16; float ss = 0.f;
#pragma unroll
                for (int bj = 0; bj < 2; ++bj) { const f32x4 v0 = acc[ai][bj][m][0], v1 = acc[ai][bj][m][1];
                    ss += (v0[0] * v0[0] + v0[1] * v0[1]) + (v0[2] * v0[2] + v0[3] * v0[3]) + (v1[0] * v1[0] + v1[1] * v1[1]) + (v1[2] * v1[2] + v1[3] * v1[3]); }
                ss += __shfl_xor(ss, 16); ss += __shfl_xor(ss, 32);
                if (fq == 0) atomicAdd(rowsq + row, ss); }
        asm volatile("s_waitcnt vmcnt(0)" ::: "memory");
        __syncthreads();
        if (threadIdx.x == 0) {
            __hip_atomic_fetch_add(pcnt + u.pm, 1u, __ATOMIC_RELEASE, __HIP_MEMORY_SCOPE_AGENT);
            unsigned sp = 0;
            while (__hip_atomic_load(pcnt + u.pm, __ATOMIC_ACQUIRE, __HIP_MEMORY_SCOPE_AGENT) < 4u) { __builtin_amdgcn_s_sleep(2); if (++sp > (1u << 22)) break; }
        }
        __syncthreads();
        f32x4 gg[2][2];
#pragma unroll
        for (int bj = 0; bj < 2; ++bj)
#pragma unroll
            for (int n = 0; n < 2; ++n) { const int c = col0 + bj * HALF + 4 * n;
                gg[bj][n] = (*(const f32x4*)(adaacc + 2 * D + c) + *(const f32x4*)(b_ada + 2 * D + c)) * *(const f32x4*)(g_post + c); }
        float rs[2][4];
#pragma unroll
        for (int ai = 0; ai < 2; ++ai)
#pragma unroll
            for (int m = 0; m < 4; ++m) rs[ai][m] = __hip_atomic_load(rowsq + row0 + ai * HALF + m * 16, __ATOMIC_RELAXED, __HIP_MEMORY_SCOPE_AGENT);
#pragma unroll
        for (int ai = 0; ai < 2; ++ai) { f32x4 xv[4][2][2];
#pragma unroll
            for (int m = 0; m < 4; ++m) { const float* xr = x + (size_t)(row0 + ai * HALF + m * 16) * D + col0;
#pragma unroll
                for (int bj = 0; bj < 2; ++bj) { xv[m][bj][0] = *(const f32x4*)(xr + bj * HALF); xv[m][bj][1] = *(const f32x4*)(xr + bj * HALF + 4); } }
#pragma unroll
            for (int m = 0; m < 4; ++m) { const float rstd = __builtin_amdgcn_rsqf(rs[ai][m] * (1.f / D) + RMS_EPS);
                float* yr = y + (size_t)(row0 + ai * HALF + m * 16) * D + col0;
#pragma unroll
                for (int bj = 0; bj < 2; ++bj) {
                    *(f32x4*)(yr + bj * HALF) = xv[m][bj][0] + gg[bj][0] * (acc[ai][bj][m][0] * rstd); *(f32x4*)(yr + bj * HALF + 4) = xv[m][bj][1] + gg[bj][1] * (acc[ai][bj][m][1] * rstd); } } }
    }
};
}

__device__ __forceinline__ void transpose_item(const float* W, int K, int N, bf16_t* WT, int k0, int n0, int drow, LAS float* scr, int lane) {
    float tv[32];
#pragma unroll
    for (int i = 0; i < 32; ++i) { const int kk = 2 * i + (lane >> 5); tv[i] = W[(size_t)(k0 + kk) * N + n0 + (lane & 31)]; }
#pragma unroll
    for (int i = 0; i < 32; ++i) { const int kk = 2 * i + (lane >> 5); scr[kk * 33 + (lane & 31)] = tv[i]; }
    asm volatile("s_waitcnt lgkmcnt(0)" ::: "memory");
    const int c = lane & 7;
#pragma unroll
    for (int j = 0; j < 4; ++j) { const int n = (lane >> 3) + 8 * j; const LAS float* s = scr + (8 * c) * 33 + n;
        u32x4 o; o.x = cvt_pk_bf16(s[0 * 33], s[1 * 33]); o.y = cvt_pk_bf16(s[2 * 33], s[3 * 33]); o.z = cvt_pk_bf16(s[4 * 33], s[5 * 33]); o.w = cvt_pk_bf16(s[6 * 33], s[7 * 33]);
        *(u32x4*)(WT + (size_t)(drow + n) * K + k0 + 8 * c) = o; }
    asm volatile("s_waitcnt lgkmcnt(0)" ::: "memory");
}

constexpr int P_QD = 272, P_T = 144, P_CUM = 528, P_O = 528, P_LR = 144;
constexpr int L_QD = 0, L_KI = L_QD + 64 * P_QD, L_KET = L_KI + 64 * P_QD, L_VT = L_KET + 128 * P_T, L_SC = L_VT + 256 * P_T, L_DEC = L_SC + 64 * P_T,
              L_LR = L_DEC + 512, L_CUM = L_LR + 64 * P_LR, L_GN = L_CUM + 64 * P_CUM, L_GLA_END = L_GN + 1024, L_OT = L_CUM;
static_assert(L_GLA_END <= LDS_BYTES - 256 && P_O <= P_CUM, "GLA LDS map");

#define LBAR() asm volatile("s_waitcnt lgkmcnt(0)\n\ts_barrier" ::: "memory")

__device__ __forceinline__ void gla_load_a(const int tid, const int row0, const int h, const bf16_t* __restrict__ VT, const float* __restrict__ LR, f32x4& lr4, u32x4 (&vt4)[4]) {
    lr4 = ((const f32x4*)(LR + (size_t)row0 * 32))[tid];
    const bf16_t* vsrc = VT + ((size_t)(row0 >> 6) * 1024 + h * HV) * 64;
#pragma unroll
    for (int i = 0; i < 4; ++i) vt4[i] = *(const u32x4*)(vsrc + (size_t)(tid + 512 * i) * 8);
}
template <bool NEED_O>
__device__ __forceinline__ void gla_load_b(const int tid, const int row0, const int h,
        const bf16_t* __restrict__ Qb, const bf16_t* __restrict__ Kb, const bf16_t* __restrict__ KT, u32x2 (&ktv)[4], u32x4 (&qg)[2], u32x4 (&kg)[2]) {
    const int frow = tid >> 3, fc8 = tid & 7;
    { const bf16_t* ksrc = KT + ((size_t)(row0 >> 6) * 512 + h * HK + 16 * (tid >> 6) + (tid & 15)) * 64 + ((tid & 63) >> 4) * 4;
#pragma unroll
      for (int t = 0; t < 4; ++t) ktv[t] = *(const u32x2*)(ksrc + 16 * t); }
    if (NEED_O) {
#pragma unroll
        for (int hf = 0; hf < 2; ++hf) { const int dk0 = fc8 * 8 + hf * 64;
            qg[hf] = *(const u32x4*)(Qb + (size_t)(row0 + frow) * KW + h * HK + dk0); kg[hf] = *(const u32x4*)(Kb + (size_t)(row0 + frow) * KW + h * HK + dk0); }
    }
}
template <bool NEED_O>
__device__ __forceinline__ void gla_load(const int tid, const int row0, const int h,
        const bf16_t* __restrict__ Qb, const bf16_t* __restrict__ Kb, const bf16_t* __restrict__ KT, const bf16_t* __restrict__ VT, const float* __restrict__ LR,
        f32x4& lr4, u32x4 (&vt4)[4], u32x2 (&ktv)[4], u32x4 (&qg)[2], u32x4 (&kg)[2]) {
    gla_load_a(tid, row0, h, VT, LR, lr4, vt4); gla_load_b<NEED_O>(tid, row0, h, Qb, Kb, KT, ktv, qg, kg);
}

template <bool NEED_O>
__device__ __forceinline__ void gla_chunk(LAS unsigned char* lds, const int tid_in, const int row0, const int row0_next, const int h, const int dir,
        const bf16_t* __restrict__ Qb, const bf16_t* __restrict__ Kb, const bf16_t* __restrict__ KT, const bf16_t* __restrict__ VT, const float* __restrict__ LR,
        const bf16x8 ub1, const bf16x8 ub2, const float bias, f32x4 (&St)[8][2], float& ltot,
        bf16_t* OFb, bf16_t* SGG, const float* __restrict__ gnorm,
        f32x4& lr4, u32x4 (&vt4)[4], u32x2 (&ktv)[4], u32x4 (&qg)[2], u32x4 (&kg)[2]) {
    int tid = tid_in; asm volatile("" : "+v"(tid));
    const int w = __builtin_amdgcn_readfirstlane(tid >> 6);
    const int frow = tid >> 3, fc8 = tid & 7;
    const size_t gi = (size_t)(row0 + frow) * D + h * HV + fc8 * 32;
    u32x4 ofg[4], sgg[4];
    if (NEED_O) {
        if (dir == 1) {
#pragma unroll
            for (int q = 0; q < 4; ++q) { ofg[q] = *(const u32x4*)(OFb + gi + q * 8); sgg[q] = *(const u32x4*)(SGG + gi + q * 8); }
        }
    }
    LBAR();
    {
        const int row = tid >> 3, c4 = (tid & 7) * 4, dsel = c4 >> 4, c = c4 & 15;
        const unsigned h01 = cvt_pk_bf16(lr4[0], lr4[1]), h23 = cvt_pk_bf16(lr4[2], lr4[3]);
        const unsigned l01 = cvt_pk_bf16(lr4[0] - bflo(h01), lr4[1] - bfhi(h01)), l23 = cvt_pk_bf16(lr4[2] - bflo(h23), lr4[3] - bfhi(h23));
        LAS unsigned char* lp = lds + L_LR + row * P_LR + dsel * 64 + c * 2;
        *(LAS u32x2*)lp = (u32x2){h01, h23}; *(LAS u32x2*)(lp + 32) = (u32x2){l01, l23};
    }
#pragma unroll
    for (int i = 0; i < 4; ++i) { const int p = tid + 512 * i, dvr = p >> 3, c = p & 7; *(LAS u32x4*)(lds + L_VT + dvr * P_T + c * 16) = vt4[i]; }
    gla_load_a(tid, row0_next, h, VT, LR, lr4, vt4);
    LBAR();
    {
        const int fr0 = tid & 15, fq0 = (tid & 63) >> 4, dl = 16 * w + fr0;
        const LAS unsigned char* ab = lds + L_LR + fr0 * P_LR + dir * 64 + fq0 * 16;
        f32x4 la[4], cumv[4]; float exc[4], T[4];
#pragma unroll
        for (int t = 0; t < 4; ++t) { const bf16x8 af = *(const LAS bf16x8*)(ab + t * 16 * P_LR);
            f32x4 z = __builtin_amdgcn_mfma_f32_16x16x32_bf16(af, ub1, (f32x4){0.f, 0.f, 0.f, 0.f}, 0, 0, 0); z = __builtin_amdgcn_mfma_f32_16x16x32_bf16(af, ub2, z, 0, 0, 0);
#pragma unroll
            for (int jj = 0; jj < 4; ++jj) { const float zz = z[jj] + bias; la[t][jj] = (fminf(zz, 0.f) - __logf(1.f + __expf(-fabsf(zz)))) * (1.f / 16.f); } }
#pragma unroll
        for (int t = 0; t < 4; ++t) { cumv[t][0] = la[t][0]; cumv[t][1] = cumv[t][0] + la[t][1]; cumv[t][2] = cumv[t][1] + la[t][2]; cumv[t][3] = cumv[t][2] + la[t][3];
            const float g = cumv[t][3]; float inc = g; float y = __shfl_up(inc, 16); if (fq0 >= 1) inc += y; y = __shfl_up(inc, 32); if (fq0 >= 2) inc += y;
            exc[t] = inc - g; T[t] = __shfl(inc, fr0 + 48); }
        float off = 0.f;
#pragma unroll
        for (int t = 0; t < 4; ++t) { const float o2 = off + exc[t]; cumv[t] = cumv[t] + o2; off += T[t]; }
        const float tot = off;
        if (dir == 1) {
#pragma unroll
            for (int t = 0; t < 4; ++t) cumv[t] = (la[t] - cumv[t]) + tot;
        }
        if (fq0 == 0) { ((LAS float*)(lds + L_DEC))[dl] = __expf(tot); ltot += tot; }
        LAS unsigned char* kt = lds + L_KET + dl * P_T + fq0 * 8;
#pragma unroll
        for (int t = 0; t < 4; ++t) { const f32x4 k4 = (f32x4){bflo(ktv[t].x), bfhi(ktv[t].x), bflo(ktv[t].y), bfhi(ktv[t].y)}; f32x4 ke;
#pragma unroll
            for (int jj = 0; jj < 4; ++jj) { ke[jj] = k4[jj] * __expf(tot - cumv[t][jj]);
                if (NEED_O) *(LAS float*)(lds + L_CUM + (16 * t + 4 * fq0 + jj) * P_CUM + dl * 4) = cumv[t][jj]; }
            *(LAS u32x2*)(kt + t * 32) = (u32x2){cvt_pk_bf16(ke[0], ke[1]), cvt_pk_bf16(ke[2], ke[3])}; }
    }
    if (NEED_O) {
        LBAR();
        const int row = tid >> 3, c8 = tid & 7;
#pragma unroll
        for (int hf = 0; hf < 2; ++hf) { const int dk0 = c8 * 8 + hf * 64;
            f32x4 q0, q1, k0, k1; pg8::unpack8(qg[hf], q0, q1); pg8::unpack8(kg[hf], k0, k1);
            const f32x4 c0 = *(const LAS f32x4*)(lds + L_CUM + row * P_CUM + dk0 * 4), c1 = *(const LAS f32x4*)(lds + L_CUM + row * P_CUM + dk0 * 4 + 16);
#pragma unroll
            for (int e = 0; e < 4; ++e) { q0[e] *= __expf(c0[e]); q1[e] *= __expf(c1[e]); k0[e] *= __expf(-c0[e]); k1[e] *= __expf(-c1[e]); }
            *(LAS u32x4*)(lds + L_QD + row * P_QD + dk0 * 2) = pg8::pack8(q0, q1);
            *(LAS u32x4*)(lds + L_KI + row * P_QD + dk0 * 2) = pg8::pack8(k0, k1); }
    }
    gla_load_b<NEED_O>(tid, row0_next, h, Qb, Kb, KT, ktv, qg, kg);
    LBAR();
    asm volatile("" : "+v"(tid));
    const int fr = tid & 15, fq = (tid & 63) >> 4;
    if (NEED_O) {
        {
            const int it = w >> 1, jt0 = (w & 1) * 2;
            f32x4 p[2] = {(f32x4){0.f, 0.f, 0.f, 0.f}, (f32x4){0.f, 0.f, 0.f, 0.f}};
            const LAS unsigned char* qb_ = lds + L_QD + fr * P_QD + fq * 16 + it * 16 * P_QD;
            const LAS unsigned char* kb_ = lds + L_KI + fr * P_QD + fq * 16 + jt0 * 16 * P_QD;
#pragma unroll
            for (int ks = 0; ks < 4; ++ks) {
                const bf16x8 qf = *(const LAS bf16x8*)(qb_ + ks * 64);
#pragma unroll
                for (int t = 0; t < 2; ++t) { const bf16x8 kf = *(const LAS bf16x8*)(kb_ + t * 16 * P_QD + ks * 64);
                    p[t] = __builtin_amdgcn_mfma_f32_16x16x32_bf16(kf, qf, p[t], 0, 0, 0); } }
            LAS unsigned char* sw = lds + L_SC + (it * 16 + fr) * P_T + (jt0 * 16 + fq * 4) * 2;
#pragma unroll
            for (int t = 0; t < 2; ++t) { const int i = it * 16 + fr, jb = (jt0 + t) * 16 + fq * 4; float v[4];
#pragma unroll
                for (int jj = 0; jj < 4; ++jj) { const int j = jb + jj; const bool keep = (dir == 0) ? (j <= i) : (j > i); v[jj] = keep ? p[t][jj] : 0.f; }
                *(LAS u32x2*)(sw + t * 32) = (u32x2){cvt_pk_bf16(v[0], v[1]), cvt_pk_bf16(v[2], v[3])}; }
        }
        LBAR();
        f32x4 o[4][2];
#pragma unroll
        for (int a = 0; a < 4; ++a) { o[a][0] = (f32x4){0.f, 0.f, 0.f, 0.f}; o[a][1] = (f32x4){0.f, 0.f, 0.f, 0.f}; }
        {
            const LAS unsigned char* vb_ = lds + L_VT + ((2 * w) * 16 + fr) * P_T + fq * 16;
            const LAS unsigned char* sb_ = lds + L_SC + fr * P_T + fq * 16;
#pragma unroll
            for (int ks = 0; ks < 2; ++ks) { bf16x8 vf[2];
#pragma unroll
                for (int bb = 0; bb < 2; ++bb) vf[bb] = *(const LAS bf16x8*)(vb_ + bb * 16 * P_T + ks * 64);
#pragma unroll
                for (int a = 0; a < 4; ++a) { const bf16x8 sf = *(const LAS bf16x8*)(sb_ + a * 16 * P_T + ks * 64);
#pragma unroll
                    for (int bb = 0; bb < 2; ++bb) o[a][bb] = __builtin_amdgcn_mfma_f32_16x16x32_bf16(sf, vf[bb], o[a][bb], 0, 0, 0); } }
            const LAS unsigned char* qa_ = lds + L_QD + fr * P_QD + fq * 8;
#pragma unroll
            for (int p = 0; p < 4; ++p) { bf16x8 sb[2];
#pragma unroll
                for (int bb = 0; bb < 2; ++bb) { const f32x4 s0 = St[2 * p][bb], s1 = St[2 * p + 1][bb];
                    const u32x4 pk = (u32x4){cvt_pk_bf16(s0[0], s0[1]), cvt_pk_bf16(s0[2], s0[3]), cvt_pk_bf16(s1[0], s1[1]), cvt_pk_bf16(s1[2], s1[3])};
                    sb[bb] = __builtin_bit_cast(bf16x8, pk); }
#pragma unroll
                for (int a = 0; a < 4; ++a) {
                    const u32x2 lo = *(const LAS u32x2*)(qa_ + a * 16 * P_QD + p * 64), hi = *(const LAS u32x2*)(qa_ + a * 16 * P_QD + p * 64 + 32);
                    const bf16x8 qa = __builtin_bit_cast(bf16x8, (u32x4){lo.x, lo.y, hi.x, hi.y});
#pragma unroll
                    for (int bb = 0; bb < 2; ++bb) o[a][bb] = __builtin_amdgcn_mfma_f32_16x16x32_bf16(qa, sb[bb], o[a][bb], 0, 0, 0); }
                __builtin_amdgcn_sched_barrier(0); }
        }
        {
            LAS unsigned char* ot = lds + L_OT + (fq * 4) * P_O + ((2 * w) * 16 + fr) * 2;
#pragma unroll
            for (int a = 0; a < 4; ++a)
#pragma unroll
                for (int jj = 0; jj < 4; ++jj) {
                    *(LAS bf16_t*)(ot + (a * 16 + jj) * P_O) = (bf16_t)(cvt_pk_bf16(o[a][0][jj], 0.f) & 0xffffu);
                    *(LAS bf16_t*)(ot + (a * 16 + jj) * P_O + 32) = (bf16_t)(cvt_pk_bf16(o[a][1][jj], 0.f) & 0xffffu); }
        }
        LBAR();
        {
            const int row = tid >> 3, c8 = tid & 7;
            const LAS unsigned char* orow = lds + L_OT + row * P_O + c8 * 64;
            if (dir == 0) {
#pragma unroll
                for (int q = 0; q < 4; ++q) *(u32x4*)(OFb + gi + q * 8) = *(const LAS u32x4*)(orow + q * 16);
            } else {
                f32x4 val[8]; float ss = 0.f;
#pragma unroll
                for (int q = 0; q < 4; ++q) { f32x4 a0, a1, b0, b1; pg8::unpack8(*(const LAS u32x4*)(orow + q * 16), a0, a1); pg8::unpack8(ofg[q], b0, b1);
                    val[2 * q] = a0 + b0; val[2 * q + 1] = a1 + b1;
#pragma unroll
                    for (int e = 0; e < 4; ++e) ss += val[2 * q][e] * val[2 * q][e] + val[2 * q + 1][e] * val[2 * q + 1][e]; }
                ss += dppx<0xB1>(ss); ss += dppx<0x4E>(ss); ss += dppx<0x141>(ss);
                const float rstd = __builtin_amdgcn_rsqf(ss * (1.f / HV) + RMS_EPS);
#pragma unroll
                for (int q = 0; q < 4; ++q) { f32x4 g0, g1; pg8::unpack8(sgg[q], g0, g1);
                    const f32x4 n0 = *(const LAS f32x4*)(lds + L_GN + (c8 * 32 + q * 8) * 4), n1 = *(const LAS f32x4*)(lds + L_GN + (c8 * 32 + q * 8) * 4 + 16);
                    *(u32x4*)(SGG + gi + q * 8) = pg8::pack8(val[2 * q] * rstd * n0 * g0, val[2 * q + 1] * rstd * n1 * g1); }
            }
        }
    }
    if (!NEED_O || row0_next != row0) {
        const LAS unsigned char* dp = lds + L_DEC + fq * 16;
#pragma unroll
        for (int a = 0; a < 8; ++a) { const f32x4 dc = *(const LAS f32x4*)(dp + a * 64); St[a][0] *= dc; St[a][1] *= dc; }
        const LAS unsigned char* vb_ = lds + L_VT + ((2 * w) * 16 + fr) * P_T + fq * 16;
        const LAS unsigned char* kb_ = lds + L_KET + fr * P_T + fq * 16;
#pragma unroll
        for (int ks = 0; ks < 2; ++ks) { bf16x8 vf[2];
#pragma unroll
            for (int bb = 0; bb < 2; ++bb) vf[bb] = *(const LAS bf16x8*)(vb_ + bb * 16 * P_T + ks * 64);
#pragma unroll
            for (int a = 0; a < 8; ++a) { const bf16x8 kf = *(const LAS bf16x8*)(kb_ + a * 16 * P_T + ks * 64);
#pragma unroll
                for (int bb = 0; bb < 2; ++bb) St[a][bb] = __builtin_amdgcn_mfma_f32_16x16x32_bf16(kf, vf[bb], St[a][bb], 0, 0, 0); } }
    }
}

#define XB_TMO      128
#define XB_XCNT(j)  (256  + 64 * (j))
#define XB_XSUB(j)  (1280 + 64 * (j))
#define XB_XGEN(j)  (2304 + 64 * (j))
#define XB_TOP      3328
#define XB_TOPGEN   3392
#define XCD_BAR_WORDS 3456
#define XB_SPIN_CAP (1u << 18)
__device__ __forceinline__ unsigned xb_ld(unsigned* p)              { return __hip_atomic_load(p, __ATOMIC_RELAXED, __HIP_MEMORY_SCOPE_AGENT); }
__device__ __forceinline__ unsigned xb_add(unsigned* p, unsigned v) { return __hip_atomic_fetch_add(p, v, __ATOMIC_RELAXED, __HIP_MEMORY_SCOPE_AGENT); }
__device__ __forceinline__ unsigned xb_xcc_id() { return (unsigned)__builtin_amdgcn_s_getreg((3 << 11) | 20) & 0xFu; }
#define XB_SPIN(cond, bar) do { unsigned _sp = 0; while (cond) { __builtin_amdgcn_s_sleep(1); \
    if ((++_sp & 255u) == 0u) { if (xb_ld(&(bar)[XB_TMO])) break; if (_sp > XB_SPIN_CAP) { atomicAdd(&(bar)[XB_TMO], 1u); break; } } } } while (0)
__device__ __forceinline__ void xcd_barrier_complete(unsigned* bar, unsigned x, unsigned& nloc, unsigned& nx) {
    const unsigned G = gridDim.x;
    unsigned sum, cnt, mine, sp = 0u;
    for (;;) {
        sum = 0u; cnt = 0u; mine = 0u;
#pragma unroll
        for (unsigned j = 0; j < 16; ++j) { const unsigned c = xb_ld(&bar[XB_XCNT(j)]); sum += c; cnt += (c > 0u) ? 1u : 0u; mine = (j == x) ? c : mine; }
        if (sum == G) break;
        __builtin_amdgcn_s_sleep(1);
        if ((++sp & 255u) == 0u) { if (xb_ld(&bar[XB_TMO])) break; if (sp > XB_SPIN_CAP) { atomicAdd(&bar[XB_TMO], 1u); break; } }
    }
    nloc = mine > 0u ? mine : 1u; nx = cnt > 0u ? cnt : 1u;
}
__device__ __forceinline__ void xcd_barrier(unsigned* bar, volatile LAS unsigned* st) {
    asm volatile("s_waitcnt vmcnt(0)" ::: "memory");
    __syncthreads();
    if (threadIdx.x == 0) {
        const unsigned x = xb_xcc_id();
        __builtin_amdgcn_s_waitcnt(0);
        unsigned nloc = st[0], nx = st[1];
        if (nloc == 0u) { xcd_barrier_complete(bar, x, nloc, nx); st[0] = nloc; st[1] = nx; }
        const unsigned old = xb_add(&bar[XB_XSUB(x)], 1u);
        const unsigned gen = old / nloc;
        if (old + 1u == (gen + 1u) * nloc) {
            __builtin_amdgcn_fence(__ATOMIC_RELEASE, "agent");
            asm volatile("s_waitcnt vmcnt(0)" ::: "memory");
            const unsigned og = xb_add(&bar[XB_TOP], 1u);
            const unsigned tg = og / nx;
            if (og + 1u == (tg + 1u) * nx) xb_add(&bar[XB_TOPGEN], 1u);
            else XB_SPIN(xb_ld(&bar[XB_TOPGEN]) == tg, bar);
            __builtin_amdgcn_fence(__ATOMIC_ACQUIRE, "agent");
            xb_add(&bar[XB_XGEN(x)], 1u);
            asm volatile("s_waitcnt vmcnt(0)" ::: "memory");
        } else {
            XB_SPIN(xb_ld(&bar[XB_XGEN(x)]) == gen, bar);
            __builtin_amdgcn_fence(__ATOMIC_ACQUIRE, "agent");
            asm volatile("s_waitcnt vmcnt(0)" ::: "memory");
        }
    }
    __syncthreads();
}

template <int HW>
__device__ __forceinline__ void pool_item(const bf16_t* __restrict__ PIN, const bf16_t* SPG, bf16_t* A2, const int r0, const int c0) {
    u32x4 rows[8 + 2 * HW], gt[8];
#pragma unroll
    for (int i = 0; i < 8 + 2 * HW; ++i) { const int r = r0 - HW + i; rows[i] = (r >= 0 && r < S) ? *(const u32x4*)(PIN + (size_t)r * D + c0) : (u32x4){0u, 0u, 0u, 0u}; }
#pragma unroll
    for (int i = 0; i < 8; ++i) gt[i] = *(const u32x4*)(SPG + (size_t)(r0 + i) * D + c0);
    f32x4 s0 = (f32x4){0.f, 0.f, 0.f, 0.f}, s1 = s0;
#pragma unroll
    for (int i = 0; i < 2 * HW; ++i) { f32x4 a, b; pg8::unpack8(rows[i], a, b); s0 += a; s1 += b; }
#pragma unroll
    for (int i = 0; i < 8; ++i) { const int s = r0 + i; const int lo_ = s - HW < 0 ? 0 : s - HW, hi_ = s + HW > S ? S : s + HW; const float inv = 1.f / (float)(hi_ - lo_);
        f32x4 a, b, g0, g1; pg8::unpack8(rows[HW + i], a, b); pg8::unpack8(gt[i], g0, g1);
        *(u32x4*)(A2 + (size_t)s * D + c0) = pg8::pack8((s0 * inv - a) * g0, (s1 * inv - b) * g1);
        if (i < 7) { f32x4 na, nb, oa, ob; pg8::unpack8(rows[2 * HW + i], na, nb); pg8::unpack8(rows[i], oa, ob); s0 += na - oa; s1 += nb - ob; } }
}

struct Args { const float* in[17]; float* out; unsigned char* ws; int ph_lo, ph_hi; };

__global__ void __launch_bounds__(NTHREADS, 2) fwd_kernel(Args args) {
    extern __shared__ __attribute__((aligned(16))) unsigned char lds_raw[];
    LAS unsigned char* lds = (LAS unsigned char*)lds_raw;
    cg::grid_group grid = cg::this_grid();
    const int tid = threadIdx.x, lane = tid & 63, wave = __builtin_amdgcn_readfirstlane(tid >> 6);
    const int G = gridDim.x, bid = blockIdx.x;
    const int gw = bid * NWAVES + wave, NGW = G * NWAVES;
    typedef const __attribute__((address_space(4))) unsigned char* kptr_t;
#define KP_DECL kptr_t kp = (kptr_t)__builtin_amdgcn_kernarg_segment_ptr(); asm volatile("" : "+s"(kp)); unsigned char* ws = *(unsigned char* const __attribute__((address_space(4)))*)(kp + 144); (void)ws
#define KIN(i) (*(const float* const __attribute__((address_space(4)))*)(kp + 8 * (i)))
#define KOUT (*(float* const __attribute__((address_space(4)))*)(kp + 136))
    int lo, hi; { kptr_t kp0 = (kptr_t)__builtin_amdgcn_kernarg_segment_ptr(); lo = *(const int __attribute__((address_space(4)))*)(kp0 + 152); hi = *(const int __attribute__((address_space(4)))*)(kp0 + 156); }
#ifndef PHMASK
#define PHMASK 0x7ff
#endif
#define IN(k) (((PHMASK >> (k)) & 1) && lo <= (k) && (k) < hi)
    volatile LAS unsigned* bst = (volatile LAS unsigned*)(lds + LDS_BYTES - 256);
    if (threadIdx.x == 0) { bst[0] = 0u; bst[1] = 0u;
        if (hi - lo > 1) { unsigned* bar0 = (unsigned*)(*(unsigned char* const __attribute__((address_space(4)))*)((kptr_t)__builtin_amdgcn_kernarg_segment_ptr() + 144) + WS_BAR); (void)xb_add(&bar0[XB_XCNT(xb_xcc_id())], 1u); } }
    __syncthreads();
#ifdef TPROBE
#define TS(k) do { if (blockIdx.x == 0 && threadIdx.x == 0) ((volatile LAS unsigned long long*)(lds + LDS_BYTES - 192))[k] = __builtin_amdgcn_s_memrealtime(); } while (0)
#else
#define TS(k) do { } while (0)
#endif
#define SEAM(k) do { if (IN(k) && IN((k) + 1)) { if ((k) == 0 && hi == 0x7fffffff) grid.sync(); else { \
        unsigned* bar_ = (unsigned*)(*(unsigned char* const __attribute__((address_space(4)))*)((kptr_t)__builtin_amdgcn_kernarg_segment_ptr() + 144) + WS_BAR); \
        xcd_barrier(bar_, bst); } } } while (0)

    TS(0);
    if (IN(0)) {
        KP_DECL; const float* cvec = KIN(1); const float* w_ada = KIN(2); const float* w_in = KIN(6); const float* pool_w = KIN(7); const float* w_pp = KIN(14); const float* w_pg = KIN(15); const float* w_out = KIN(16);
        float* adaacc = (float*)(ws + WS_ADA); bf16_t* WIN = (bf16_t*)(ws + WS_WIN); bf16_t* WPP = (bf16_t*)(ws + WS_WPP); bf16_t* WPG = (bf16_t*)(ws + WS_WPG); bf16_t* WOUT = (bf16_t*)(ws + WS_WOUT); bf16_t* POOLW = (bf16_t*)(ws + WS_POOLW);
        for (int it = gw; it < 48 * 64; it += NGW) { const int nc = it % 48, ksl = it / 48; const int n = nc * 64 + lane; float s = 0.f;
#pragma unroll
            for (int kk = 0; kk < 16; ++kk) { const int k = ksl * 16 + kk; const float cv = cvec[k]; s += cv * sigmoidf_(cv) * w_ada[(size_t)k * (3 * D) + n]; }
            atomicAdd(adaacc + n, s); }
        LAS float* scr = (LAS float*)(lds + wave * 16384);
        for (int it = gw; it < 16 + 128; it += NGW) {
            if (it < 16) transpose_item(w_in, D, 7200, WIN, it * 64, 160 * 32, NPROJ, scr, lane);
            else { const int r = it - 16, gI = r / 32, rr = r % 32; const int kb = rr / 8, nb = rr % 8;
                transpose_item(pool_w + (size_t)gI * 65536, 256, 256, POOLW, kb * 64, nb * 32, gI * 256 + nb * 32, scr, lane); } }
        { bf16_t* WINP = (bf16_t*)(ws + WS_WINP);
          for (int i = bid * NTHREADS + tid; i < D * D / 4; i += G * NTHREADS) { const int k = i >> 8, c4 = (i & 255) * 4; const f32x4 v = *(const f32x4*)(w_in + (size_t)k * 7200 + c4);
              *(u32x2*)(WINP + (size_t)k * D + c4) = (u32x2){cvt_pk_bf16(v[0], v[1]), cvt_pk_bf16(v[2], v[3])}; } }
    }
    SEAM(0); TS(1);

    if (IN(1)) {
        KP_DECL; const float* x = KIN(0); const float* b_ada = KIN(3); const float* g_pre = KIN(4); const float* adaacc = (const float*)(ws + WS_ADA); bf16_t* WIN = (bf16_t*)(ws + WS_WIN); float* LR = (float*)(ws + WS_LR); bf16_t* H = (bf16_t*)KOUT;
        {
            const float* pool_scale = KIN(8);
            pg8::Gemm gf{(const bf16_t*)(ws + WS_POOLW), (const bf16_t*)(ws + WS_WINP), D, D, 256, 256, 0, -1, -1, D, 256}; pg8::StaticOrder sof; sof.init(D, D, G, bid);
            pg8::EpiFold Ef{WIN, pool_scale};
            pg8::gemm_phase<pg8::EpiFold>(lds, gf, sof, Ef);
        }
        {
            const float* w_in = KIN(6); const float* pool_w = KIN(7); const float* w_pp = KIN(14); const float* w_pg = KIN(15); const float* w_out = KIN(16);
            bf16_t* WPP = (bf16_t*)(ws + WS_WPP); bf16_t* WPG = (bf16_t*)(ws + WS_WPG); bf16_t* WOUT = (bf16_t*)(ws + WS_WOUT); bf16_t* POOLW = (bf16_t*)(ws + WS_POOLW);
            LAS float* scr = (LAS float*)(lds + wave * 16384);
            constexpr int I_IN = 16 * 225, I_SQ = 16 * 32, I_PW = 4 * 8;
            constexpr int NIT = I_IN + 3 * I_SQ;
            const int nfold = G > 64 ? 16 : 0;
            for (int it = (bid - nfold) * NWAVES + wave; it < NIT && bid >= nfold; it += (G - nfold) * NWAVES) { int r = it;
                if (r < I_IN) { const int kb = r / 225, nb = r % 225; if (nb == 160 || nb < 32) continue; const int drow = nb < 160 ? nb * 32 : (nb - 1) * 32;
                    transpose_item(w_in, D, 7200, WIN, kb * 64, nb * 32, drow, scr, lane); continue; } r -= I_IN;
                if (r < 3 * I_SQ) { const int which = r / I_SQ, rr = r % I_SQ; const int kb = rr / 32, nb = rr % 32;
                    const float* W = which == 0 ? w_pp : (which == 1 ? w_pg : w_out); bf16_t* WT = which == 0 ? WPP : (which == 1 ? WPG : WOUT);
                    transpose_item(W, D, D, WT, kb * 64, nb * 32, nb * 32, scr, lane); continue; } r -= 3 * I_SQ;
            }
            __syncthreads();
        }
        constexpr int HS_PITCH = 2064;
        constexpr int L_HS = 0, L_RED = 16 * HS_PITCH;
        f32x4 gs[4], sh[4];
#pragma unroll
        for (int j = 0; j < 4; ++j) { const int c0 = 4 * lane + 256 * j;
            const f32x4 shv = *(const f32x4*)(adaacc + c0) + *(const f32x4*)(b_ada + c0);
            const f32x4 scv = *(const f32x4*)(adaacc + D + c0) + *(const f32x4*)(b_ada + D + c0);
            gs[j] = *(const f32x4*)(g_pre + c0) * (scv + 1.f); sh[j] = shv; }
        const int fr = lane & 15, fq = lane >> 4;
        bf16x8 bfr[2][4];
#pragma unroll
        for (int nt = 0; nt < 2; ++nt)
#pragma unroll
            for (int kk = 0; kk < 4; ++kk) bfr[nt][kk] = *(const bf16x8*)(WIN + (size_t)(NPROJ + nt * 16 + fr) * D + (4 * wave + kk) * 32 + fq * 8);
        f32x4 xn[2][4];
        if (bid < S / 16) {
#pragma unroll
            for (int rr = 0; rr < 2; ++rr) { const f32x4* xr = (const f32x4*)(x + ((size_t)bid * 16 + 2 * wave + rr) * D) + lane;
#pragma unroll
                for (int j = 0; j < 4; ++j) xn[rr][j] = xr[64 * j]; }
        }
        for (int grp = bid; grp < S / 16; grp += G) {
            f32x4 xc[2][4];
#pragma unroll
            for (int rr = 0; rr < 2; ++rr)
#pragma unroll
                for (int j = 0; j < 4; ++j) xc[rr][j] = xn[rr][j];
            if (grp + G < S / 16) {
#pragma unroll
                for (int rr = 0; rr < 2; ++rr) { const f32x4* xr = (const f32x4*)(x + ((size_t)(grp + G) * 16 + 2 * wave + rr) * D) + lane;
#pragma unroll
                    for (int j = 0; j < 4; ++j) xn[rr][j] = xr[64 * j]; }
            }
#pragma unroll
            for (int rr = 0; rr < 2; ++rr) { const int rl = 2 * wave + rr; const size_t row = (size_t)grp * 16 + rl;
                f32x4 v[4]; float s = 0.f;
#pragma unroll
                for (int j = 0; j < 4; ++j) { v[j] = xc[rr][j]; s += (v[j][0] * v[j][0] + v[j][1] * v[j][1]) + (v[j][2] * v[j][2] + v[j][3] * v[j][3]); }
                const float rstd = __builtin_amdgcn_rsqf(wave_sum(s) * (1.f / D) + RMS_EPS);
#pragma unroll
                for (int j = 0; j < 4; ++j) { const f32x4 hv = v[j] * rstd * gs[j] + sh[j]; const u32x2 pk = (u32x2){cvt_pk_bf16(hv[0], hv[1]), cvt_pk_bf16(hv[2], hv[3])};
                    *(u32x2*)(H + row * D + 4 * lane + 256 * j) = pk; *(LAS u32x2*)(lds + L_HS + rl * HS_PITCH + (4 * lane + 256 * j) * 2) = pk; } }
            LBAR();
            f32x4 pa[2] = {(f32x4){0.f, 0.f, 0.f, 0.f}, (f32x4){0.f, 0.f, 0.f, 0.f}};
#pragma unroll
            for (int kk = 0; kk < 4; ++kk) { const bf16x8 af = *(const LAS bf16x8*)(lds + L_HS + fr * HS_PITCH + ((4 * wave + kk) * 32 + fq * 8) * 2);
                pa[0] = __builtin_amdgcn_mfma_f32_16x16x32_bf16(af, bfr[0][kk], pa[0], 0, 0, 0); pa[1] = __builtin_amdgcn_mfma_f32_16x16x32_bf16(af, bfr[1][kk], pa[1], 0, 0, 0); }
            *(LAS f32x4*)(lds + L_RED + ((wave * 2 + 0) * 64 + lane) * 16) = pa[0]; *(LAS f32x4*)(lds + L_RED + ((wave * 2 + 1) * 64 + lane) * 16) = pa[1];
            LBAR();
            { const int nt = tid >> 8, ll = (tid >> 2) & 63, jj = tid & 3; float s = 0.f;
#pragma unroll
              for (int ww = 0; ww < 8; ++ww) s += *(const LAS float*)(lds + L_RED + ((ww * 2 + nt) * 64 + ll) * 16 + jj * 4);
              LR[((size_t)grp * 16 + (ll >> 4) * 4 + jj) * 32 + nt * 16 + (ll & 15)] = s; }
        }
        __syncthreads();
    }
    SEAM(1); TS(2);

    if (IN(2)) {
        KP_DECL; const bf16_t* H = (const bf16_t*)KOUT; const bf16_t* WIN = (const bf16_t*)(ws + WS_WIN);
        pg8::Gemm g{H, WIN, S, NPROJ, D, D, 0, 12, 16, D, 0}; pg8::StaticOrder so; so.init(S, NPROJ, G, bid, 1);
        pg8::EpiProj E{ws, (bf16_t*)((unsigned char*)KOUT + 32 * MiB)};
        pg8::gemm_phase<pg8::EpiProj>(lds, g, so, E);
    }
    SEAM(2); TS(3);

    TS(4);
    TS(5);

    if (IN(5)) {
        KP_DECL; const float* gk_up_f = KIN(9); const float* gk_bias_f = KIN(10); const float* gk_up_b = KIN(11); const float* gk_bias_b = KIN(12);
        const bf16_t* A2 = (const bf16_t*)KOUT; const bf16_t* KT = (const bf16_t*)((unsigned char*)KOUT + 32 * MiB); const bf16_t* WPP = (const bf16_t*)(ws + WS_WPP); bf16_t* SBP = (bf16_t*)(ws + WS_SBP);
        const bf16_t* Qb = (const bf16_t*)(ws + WS_Q); const bf16_t* Kb = (const bf16_t*)(ws + WS_K); const bf16_t* Vb = (const bf16_t*)(ws + WS_V); const float* LR = (const float*)(ws + WS_LR); float* LTOT = (float*)(ws + WS_LTOT); float* STATES = (float*)KOUT;
        {
        const bf16_t* PIN = (const bf16_t*)(ws + WS_PIN); const bf16_t* SPG = (const bf16_t*)(ws + WS_SPG); bf16_t* A2 = (bf16_t*)(ws + WS_SPG);
        for (int it = bid * NTHREADS + tid; it < (S / 8) * 128; it += G * NTHREADS) { const int cl = it & 31, rbs = (it >> 5) & 1, g = (it >> 6) & 3, rbp = it >> 8;
            const int r0 = (rbp * 2 + rbs) * 8, c0 = (g * 32 + cl) * 8;
            if (g == 0) pool_item<1>(PIN, SPG, A2, r0, c0); else if (g == 1) pool_item<2>(PIN, SPG, A2, r0, c0); else if (g == 2) pool_item<4>(PIN, SPG, A2, r0, c0); else pool_item<8>(PIN, SPG, A2, r0, c0); }
            }
        for (int pr = bid; pr < NSC * NH; pr += G) { f32x4 lr4; u32x4 vt4[4], qg[2], kg[2]; u32x2 ktv[4];
          for (int dir = 0; dir < 2; ++dir) { const int h = pr & 3, sc = pr >> 2;
            int tl = tid; asm volatile("" : "+v"(tl));
            const float* upp = dir ? gk_up_b : gk_up_f; const float* bp = dir ? gk_bias_b : gk_bias_f;
            const int dl = 16 * wave + (tl & 15), fqd = (tl & 63) >> 4;
            bf16x8 ub1, ub2; float bias;
            { unsigned hh[4], ll[4]; float uv[8];
#pragma unroll
              for (int e = 0; e < 8; ++e) uv[e] = upp[((fqd & 1) * 8 + e) * KW + h * HK + dl];
              bias = bp[h * HK + dl];
#pragma unroll
              for (int e2 = 0; e2 < 4; ++e2) { const float v0 = uv[2 * e2], v1 = uv[2 * e2 + 1];
                  hh[e2] = cvt_pk_bf16(v0, v1); ll[e2] = (fqd < 2) ? cvt_pk_bf16(v0 - bflo(hh[e2]), v1 - bfhi(hh[e2])) : 0u; }
              ub1 = __builtin_bit_cast(bf16x8, (u32x4){hh[0], hh[1], hh[2], hh[3]}); ub2 = __builtin_bit_cast(bf16x8, (u32x4){ll[0], ll[1], ll[2], ll[3]}); }
            f32x4 St[8][2];
#pragma unroll
            for (int a = 0; a < 8; ++a) { St[a][0] = (f32x4){0.f, 0.f, 0.f, 0.f}; St[a][1] = (f32x4){0.f, 0.f, 0.f, 0.f}; }
            float ltot = 0.f;
            if (dir == 0) gla_load<false>(tl, (sc * SCN) * CH, h, Qb, Kb, KT, Vb, LR, lr4, vt4, ktv, qg, kg);
            for (int cc = 0; cc < SCN; ++cc) { const int c = dir ? (SCN - 1 - cc) : cc; const int row0 = (sc * SCN + c) * CH;
                const int cn = (cc + 1 < SCN) ? (dir ? c - 1 : c + 1) : c; const int row0n = (sc * SCN + cn) * CH;
                gla_chunk<false>(lds, tl, row0, row0n, h, dir, Qb, Kb, KT, Vb, LR, ub1, ub2, bias, St, ltot, nullptr, nullptr, nullptr, lr4, vt4, ktv, qg, kg); }
            u32x2* sp2 = (u32x2*)((bf16_t*)STATES + ((size_t)(dir * NSC + sc) * NH + h) * (HK * HV)) + wave * 64;
#pragma unroll
            for (int a = 0; a < 8; ++a) { unsigned soa = (unsigned)(a * 1024) + (unsigned)(tl & 63); asm volatile("" : "+v"(soa));
                sp2[soa] = (u32x2){cvt_pk_bf16(St[a][0][0], St[a][0][1]), cvt_pk_bf16(St[a][0][2], St[a][0][3])};
                sp2[soa + 512] = (u32x2){cvt_pk_bf16(St[a][1][0], St[a][1][1]), cvt_pk_bf16(St[a][1][2], St[a][1][3])};
                __builtin_amdgcn_sched_barrier(0); }
            if (fqd == 0) LTOT[((size_t)(dir * NSC + sc) * NH + h) * HK + dl] = ltot;
        } }
    }
    SEAM(5); TS(6);

    if (IN(6)) {
        KP_DECL; const float* LTOT = (const float*)(ws + WS_LTOT); float* STATES = (float*)KOUT;
        typedef float f32x2 __attribute__((ext_vector_type(2)));
        for (int base = bid * NTHREADS; base < 2 * NH * 8192 * 2; base += G * NTHREADS) { const int e2 = base + tid, e = e2 >> 1, hp = e2 & 1; const int dir = e >> 15, h = (e >> 13) & 3, slot = e & 8191;
            const int a16 = (slot >> 10) * 16, dkl = ((slot >> 4) & 3) * 4 + hp * 2;
            __syncthreads();
            { float lt2[2];
#pragma unroll
              for (int u = 0; u < 2; ++u) { const int i = tid + u * NTHREADS, sc = i >> 4, c = i & 15; lt2[u] = LTOT[((size_t)(dir * NSC + sc) * NH + h) * HK + a16 + c]; }
#pragma unroll
              for (int u = 0; u < 2; ++u) ((LAS float*)lds)[tid + u * NTHREADS] = __expf(lt2[u]); }
            __syncthreads();
            f32x2 carry = (f32x2){0.f, 0.f};
            unsigned* sb = (unsigned*)STATES + (size_t)slot * 2 + hp;
            for (int i0 = 0; i0 < NSC; i0 += 16) { unsigned t[16];
#pragma unroll
                for (int u = 0; u < 16; ++u) { const int sc = dir ? (NSC - 1 - (i0 + u)) : (i0 + u); t[u] = sb[((size_t)(dir * NSC + sc) * NH + h) * (HK * HV / 2)]; }
#pragma unroll
                for (int u = 0; u < 16; ++u) { const int sc = dir ? (NSC - 1 - (i0 + u)) : (i0 + u); const f32x2 dcy = *(const LAS f32x2*)(lds + (sc * 16 + dkl) * 4);
                    sb[((size_t)(dir * NSC + sc) * NH + h) * (HK * HV / 2)] = cvt_pk_bf16(carry[0], carry[1]);
                    carry[0] = dcy[0] * carry[0] + bflo(t[u]); carry[1] = dcy[1] * carry[1] + bfhi(t[u]); } }
        }
    }
    SEAM(6); TS(7);

    if (IN(7)) {
        KP_DECL; const float* gk_up_f = KIN(9); const float* gk_bias_f = KIN(10); const float* gk_up_b = KIN(11); const float* gk_bias_b = KIN(12); const float* gla_norm_g = KIN(13);
        const bf16_t* Qb = (const bf16_t*)(ws + WS_Q); const bf16_t* Kb = (const bf16_t*)(ws + WS_K); const bf16_t* Vb = (const bf16_t*)(ws + WS_V); const float* LR = (const float*)(ws + WS_LR); const float* STATES = (const float*)KOUT;
        bf16_t* SGG = (bf16_t*)(ws + WS_SGG); bf16_t* OFb = (bf16_t*)(ws + WS_PIN); const bf16_t* KT = (const bf16_t*)((unsigned char*)KOUT + 32 * MiB);
        for (int item = bid; item < NSC * NH; item += G) { const int h = item & 3, sc = item >> 2;
            int tl = tid; asm volatile("" : "+v"(tl));
            const int d = tl & 127, fr = tl & 15, fq = (tl & 63) >> 4;
            f32x4 lr4; u32x4 vt4[4], qg[2], kg[2]; u32x2 ktv[4];
            __syncthreads(); if (tl < 64) ((LAS f32x4*)(lds + L_GN))[tl] = ((const f32x4*)gla_norm_g)[tl];
            for (int dir = 0; dir < 2; ++dir) {
                const float* upp = dir ? gk_up_b : gk_up_f; const float* bp = dir ? gk_bias_b : gk_bias_f;
                const int dl = 16 * wave + fr;
                bf16x8 ub1, ub2; float bias;
                { unsigned hh[4], ll[4]; float uv[8];
#pragma unroll
                  for (int e = 0; e < 8; ++e) uv[e] = upp[((fq & 1) * 8 + e) * KW + h * HK + dl];
                  bias = bp[h * HK + dl];
#pragma unroll
                  for (int e2 = 0; e2 < 4; ++e2) { const float v0 = uv[2 * e2], v1 = uv[2 * e2 + 1];
                      hh[e2] = cvt_pk_bf16(v0, v1); ll[e2] = (fq < 2) ? cvt_pk_bf16(v0 - bflo(hh[e2]), v1 - bfhi(hh[e2])) : 0u; }
                  ub1 = __builtin_bit_cast(bf16x8, (u32x4){hh[0], hh[1], hh[2], hh[3]}); ub2 = __builtin_bit_cast(bf16x8, (u32x4){ll[0], ll[1], ll[2], ll[3]}); }
                const u32x2* sp2 = (const u32x2*)((const bf16_t*)STATES + ((size_t)(dir * NSC + sc) * NH + h) * (HK * HV)) + wave * 64;
                if (dir == 0) gla_load<true>(tl, (sc * SCN) * CH, h, Qb, Kb, KT, Vb, LR, lr4, vt4, ktv, qg, kg);
                f32x4 St[8][2];
                { u32x2 raw[8][2];
#pragma unroll
                  for (int a = 0; a < 8; ++a) { unsigned soa = (unsigned)(a * 1024) + (unsigned)(tl & 63); asm volatile("" : "+v"(soa)); raw[a][0] = sp2[soa]; raw[a][1] = sp2[soa + 512]; }
#pragma unroll
                  for (int a = 0; a < 8; ++a) { const u32x2 p0 = raw[a][0], p1 = raw[a][1];
                    St[a][0] = (f32x4){bflo(p0.x), bfhi(p0.x), bflo(p0.y), bfhi(p0.y)}; St[a][1] = (f32x4){bflo(p1.x), bfhi(p1.x), bflo(p1.y), bfhi(p1.y)}; } }
                float ltot = 0.f;
                for (int cc = 0; cc < SCN; ++cc) { const int c = dir ? (SCN - 1 - cc) : cc; const int row0 = (sc * SCN + c) * CH;
                    const int cn = (cc + 1 < SCN) ? (dir ? c - 1 : c + 1) : c; const int row0n = (sc * SCN + cn) * CH;
                    gla_chunk<true>(lds, tl, row0, row0n, h, dir, Qb, Kb, KT, Vb, LR, ub1, ub2, bias, St, ltot, OFb, SGG, gla_norm_g, lr4, vt4, ktv, qg, kg); }
            }
        }
    }
    SEAM(7); TS(8);

    if (IN(8)) {
        KP_DECL; const bf16_t* SGG = (const bf16_t*)(ws + WS_SGG); const bf16_t* WPG = (const bf16_t*)(ws + WS_WPG); const bf16_t* SBP = (const bf16_t*)(ws + WS_SBP); bf16_t* SBG = (bf16_t*)(ws + WS_SBG);
        const bf16_t* A2 = (const bf16_t*)(ws + WS_SPG); const bf16_t* WPP = (const bf16_t*)(ws + WS_WPP);
        pg8::Gemm g{A2, WPP, S, D, D, D, 0, -1, -1, D, 0}; pg8::StaticOrder so; so.init(S, D, G, bid, 0, 1);
        pg8::EpiDual E{pg8::EpiYPool{(bf16_t*)SBP}, pg8::EpiYGla{SBP, SBG}};
        pg8::gemm_phase<pg8::EpiDual>(lds, g, so, E);
    }
    SEAM(8); TS(9);

    if (IN(9)) {
        KP_DECL; const bf16_t* SBG = (const bf16_t*)(ws + WS_SBG); const bf16_t* WOUT = (const bf16_t*)(ws + WS_WOUT); float* OUT = KOUT; float* rowsq = (float*)(ws + WS_ROWSQ);
        const float* x = KIN(0); const float* b_ada = KIN(3); const float* g_post = KIN(5); const float* adaacc = (const float*)(ws + WS_ADA);
        pg8::Gemm g{SBG, WOUT, S, D, D, D, 0, -1, -1, D, 0}; pg8::StaticOrder so; so.init(S, D, G, bid);
        if (G == (S / 256) * (D / 256)) {
            pg8::EpiOutFused E{x, OUT, rowsq, (unsigned*)(ws + WS_PCNT), adaacc, b_ada, g_post};
            pg8::gemm_phase<pg8::EpiOutFused>(lds, g, so, E);
        }
#ifdef TPROBE
        __syncthreads();
        if (blockIdx.x == 0 && threadIdx.x == 0) { asm volatile("s_waitcnt vmcnt(0)" ::: "memory"); volatile LAS unsigned long long* tsb = (volatile LAS unsigned long long*)(lds + LDS_BYTES - 192);
            float acc_us = 0.f; const unsigned msk = TPROBE;
            for (int k = 0; k < 9; ++k) if ((msk >> k) & 1u) acc_us += (float)(tsb[k + 1] - tsb[k]) * 0.01f;
            if ((msk >> 9) & 1u) acc_us += (float)(__builtin_amdgcn_s_memrealtime() - tsb[9]) * 0.01f;
            OUT[0] += acc_us * TPSCALE; }
#endif
    }
#undef IN
#undef SEAM
}

constexpr int NPHASES = 10;
extern "C" void kernel_launch(void* const* d_in, const int* in_sizes, int n_in, void* d_out, int out_size, void* d_ws, size_t ws_size, hipStream_t stream) {
    static int grid = 0;
    if (grid == 0) {
        if (n_in != 17 || out_size != S * D || ws_size < WS_END) { fprintf(stderr, "kernel_launch: unexpected problem shape (n_in %d out %d ws %zu)\n", n_in, out_size, ws_size); grid = -1; return; }
        int dev = 0, cus = 0, per_cu = 0;
        hipGetDevice(&dev); hipDeviceGetAttribute(&cus, hipDeviceAttributeMultiprocessorCount, dev);
        if (hipFuncSetAttribute((const void*)fwd_kernel, hipFuncAttributeMaxDynamicSharedMemorySize, LDS_BYTES) != hipSuccess) { fprintf(stderr, "kernel_launch: hipFuncSetAttribute failed\n"); grid = -1; return; }
        if (hipOccupancyMaxActiveBlocksPerMultiprocessor(&per_cu, (const void*)fwd_kernel, NTHREADS, LDS_BYTES) != hipSuccess || per_cu < 1) { fprintf(stderr, "kernel_launch: occupancy query says %d\n", per_cu); per_cu = 1; (void)hipGetLastError(); }
        grid = cus * 1;
        if (grid > cus * per_cu) grid = cus * per_cu;
    }
    if (grid < 0) return;
    hipMemsetAsync((char*)d_ws + WS_CTL, 0, CTL_ZERO_BYTES, stream);
    Args a{};
    for (int i = 0; i < 17; ++i) a.in[i] = (const float*)d_in[i];
    a.out = (float*)d_out; a.ws = (unsigned char*)d_ws;
#if ONE_LAUNCH
    a.ph_lo = 0; a.ph_hi = NPHASES;
    void* kargs[] = {&a};
    hipError_t e = hipLaunchCooperativeKernel((const void*)fwd_kernel, dim3(grid), dim3(NTHREADS), kargs, LDS_BYTES, stream);
    if (e != hipSuccess) fprintf(stderr, "cooperative launch failed: %s (grid %d)\n", hipGetErrorString(e), grid);
#else
    for (int p = 0; p < NPHASES; ++p) { a.ph_lo = p; a.ph_hi = p + 1;
        hipLaunchKernelGGL(fwd_kernel, dim3(grid), dim3(NTHREADS), LDS_BYTES, stream, a); }
#endif
}
```
